# Optimizing an MI355X kernel written in HIP

```python
import jax
import jax.numpy as jnp
from jax import lax
import numpy as np

D_MODEL = 2048
BATCH = 1
SEQ = 8192
DEPTH = 4

GRID_W = 64
RET_HEADS = 4
RET_HEAD_DIM = 256
RET_WIDTH = RET_HEADS * RET_HEAD_DIM
RET_CHUNK = 128
NA_HEADS = 8
NA_HEAD_DIM = 128
NA_WIDTH = NA_HEADS * NA_HEAD_DIM
NA_KH = 8
NA_KW = 16
LRU_WIDTH = 1024
LRU_BLOCKS = 8
LRU_BLOCK_DIM = LRU_WIDTH // LRU_BLOCKS
LRU_CONV = 4
LRU_C = 8.0
N_BRANCH = 3
BRANCH_WIDTH = 1024
IN_COLS = 4 * RET_WIDTH + 3 * NA_WIDTH + 2 * LRU_WIDTH + N_BRANCH * D_MODEL
D_FF = -(-8 * D_MODEL // (3 * 256)) * 256
DEEPNORM_ALPHA = (2 * DEPTH) ** 0.25
DEEPNORM_BETA = (8 * DEPTH) ** -0.25
LN_EPS = 1e-5
ROPE_BASE = 10000.0

kernel_name = 'hybrid_retention_natten_rglru_encoder'


def layer_norm(x, g, b):
    xf = x.astype(jnp.float32)
    mu = jnp.mean(xf, axis=-1, keepdims=True)
    var = jnp.mean(jnp.square(xf - mu), axis=-1, keepdims=True)
    y = (xf - mu) * lax.rsqrt(var + LN_EPS)
    return (y * g.astype(jnp.float32) + b.astype(jnp.float32)).astype(x.dtype)


def split_columns(proj):
    sizes = [RET_WIDTH] * 4 + [NA_WIDTH] * 3 + [LRU_WIDTH] * 2 + [N_BRANCH * D_MODEL]
    parts = []
    start = 0
    for w in sizes:
        parts.append(proj[..., start:start + w])
        start += w
    return parts


def rotary(t, pos):
    half = t.shape[-1] // 2
    inv = ROPE_BASE ** (-jnp.arange(half, dtype=jnp.float32) / half)
    ang = pos[:, None] * inv[None, :]
    cos = jnp.cos(ang)[None, :, None, :]
    sin = jnp.sin(ang)[None, :, None, :]
    t1 = t[..., :half].astype(jnp.float32)
    t2 = t[..., half:].astype(jnp.float32)
    return jnp.concatenate([t1 * cos - t2 * sin, t1 * sin + t2 * cos], axis=-1)


def decay_masks(log_g, strict):
    idx = jnp.arange(RET_CHUNK, dtype=jnp.float32)
    diff = idx[:, None] - idx[None, :]
    keep = (diff > 0) if strict else (diff >= 0)
    expo = jnp.where(keep, diff, 0.0)[None] * log_g[:, None, None]
    inner = jnp.where(keep[None], jnp.exp(expo), 0.0)
    q_dec = jnp.exp((idx + 1.0)[None, :] * log_g[:, None])
    k_dec = jnp.exp((RET_CHUNK - 1.0 - idx)[None, :] * log_g[:, None])
    c_dec = jnp.exp(RET_CHUNK * log_g)
    return inner, q_dec, k_dec, c_dec


def retention_one_direction(q, k, v, log_g, strict):
    b, h, s, d = q.shape
    nc = s // RET_CHUNK
    q = q.reshape(b, h, nc, RET_CHUNK, d)
    k = k.reshape(b, h, nc, RET_CHUNK, d)
    v = v.reshape(b, h, nc, RET_CHUNK, v.shape[-1])
    inner, q_dec, k_dec, c_dec = decay_masks(log_g, strict)
    scores = jnp.einsum('bhncd,bhnmd->bhncm', q, k) * inner[None, :, None]
    intra = jnp.einsum('bhncm,bhnme->bhnce', scores, v)
    kv = jnp.einsum('bhncd,bhnce->nbhde', k * k_dec[None, :, None, :, None], v)
    decay = c_dec[None, :, None, None]

    def step(state, kv_n):
        return decay * state + kv_n, state

    _, prev = lax.scan(step, jnp.zeros_like(kv[0]), kv)
    inter = jnp.einsum('bhncd,nbhde->bhnce', q * q_dec[None, :, None, :, None], prev)
    return (intra + inter).reshape(b, h, s, -1)


def retention_branch(q, k, v, g, decay_logits):
    b, s, _ = q.shape
    pos = jnp.arange(s, dtype=jnp.float32)
    heads = lambda t: t.reshape(b, s, RET_HEADS, RET_HEAD_DIM)
    to_bhsd = lambda t: jnp.transpose(t, (0, 2, 1, 3)).astype(jnp.float32)
    qh = to_bhsd(rotary(heads(q), pos))
    kh = to_bhsd(rotary(heads(k), pos) * (RET_HEAD_DIM ** -0.5))
    vh = to_bhsd(heads(v))
    log_g = jax.nn.log_sigmoid(decay_logits.astype(jnp.float32))
    flip = lambda t: jnp.flip(t, axis=2)
    fwd = retention_one_direction(qh, kh, vh, log_g[0], strict=False)
    bwd = flip(retention_one_direction(flip(qh), flip(kh), flip(vh), log_g[1], strict=True))
    y = fwd + bwd
    mu = jnp.mean(y, axis=-1, keepdims=True)
    var = jnp.mean(jnp.square(y - mu), axis=-1, keepdims=True)
    y = (y - mu) * lax.rsqrt(var + LN_EPS)
    y = jnp.transpose(y, (0, 2, 1, 3)).reshape(b, s, RET_WIDTH)
    return (jax.nn.silu(g.astype(jnp.float32)) * y).astype(g.dtype)


def neighborhood_attention_branch(q, k, v, rpb):
    b, s, _ = q.shape
    rows = s // GRID_W
    kh = min(NA_KH, rows)
    kw = NA_KW
    grid = lambda t: jnp.transpose(t.reshape(b, rows, GRID_W, NA_HEADS, NA_HEAD_DIM), (0, 3, 1, 2, 4))
    qg, kg, vg = grid(q), grid(k), grid(v)
    r = jnp.arange(rows)
    row_start = jnp.clip(r - kh // 2, 0, rows - kh)
    key_rows = row_start[:, None] + jnp.arange(kh)[None, :]
    k_strip = kg[:, :, key_rows]
    v_strip = vg[:, :, key_rows]
    c = jnp.arange(GRID_W)
    col_start = jnp.clip(c - kw // 2, 0, GRID_W - kw)
    in_win = (c[None, :] >= col_start[:, None]) & (c[None, :] < col_start[:, None] + kw)
    dr = key_rows - r[:, None] + (NA_KH - 1)
    dc = jnp.clip(c[None, :] - c[:, None], -(kw - 1), kw - 1) + (kw - 1)
    bias = rpb.astype(jnp.float32)[:, dr[:, None, :, None], dc[None, :, None, :]]
    scores = jnp.einsum('bhrcd,bhrkwd->bhrckw', qg, k_strip).astype(jnp.float32) * (NA_HEAD_DIM ** -0.5)
    scores = jnp.where(in_win[:, None, :], scores + bias[None], -jnp.inf)
    p = jax.nn.softmax(scores, axis=(-2, -1)).astype(v.dtype)
    out = jnp.einsum('bhrckw,bhrkwd->bhrcd', p, v_strip)
    return jnp.transpose(out, (0, 2, 3, 1, 4)).reshape(b, s, NA_WIDTH)


def linear_combine(left, right):
    a_l, b_l = left
    a_r, b_r = right
    return a_l * a_r, a_r * b_l + b_r


def rglru_branch(xb, yb, w_conv, b_conv, wa, ba, wi, bi, lam):
    b, s, _ = xb.shape
    xc = lax.conv_general_dilated(
        xb, w_conv.astype(xb.dtype)[:, None, :], window_strides=(1,),
        padding=[(LRU_CONV // 2, LRU_CONV - 1 - LRU_CONV // 2)],
        dimension_numbers=('NWC', 'WIO', 'NWC'), feature_group_count=LRU_WIDTH) + b_conv
    xf = xc.astype(jnp.float32)
    xblk = xf.reshape(b, s, LRU_BLOCKS, LRU_BLOCK_DIM)

    def direction(d, reverse):
        r_gate = jax.nn.sigmoid(jnp.einsum('bsni,nij->bsnj', xblk, wa[d].astype(jnp.float32)).reshape(b, s, LRU_WIDTH)
                                + ba[d].astype(jnp.float32))
        i_gate = jax.nn.sigmoid(jnp.einsum('bsni,nij->bsnj', xblk, wi[d].astype(jnp.float32)).reshape(b, s, LRU_WIDTH)
                                + bi[d].astype(jnp.float32))
        log_a = -LRU_C * r_gate * jax.nn.softplus(-lam[d].astype(jnp.float32))
        a = jnp.exp(log_a)
        inp = jnp.sqrt(-jnp.expm1(2.0 * log_a)) * (i_gate * xf)
        _, h = lax.associative_scan(linear_combine, (a, inp), axis=1, reverse=reverse)
        return h

    h = direction(0, False) + direction(1, True)
    return (h * jax.nn.gelu(yb.astype(jnp.float32))).astype(xb.dtype)


def hybrid_mixer(x, w_in, gate_b, ret_decay, w_conv, b_conv, lru_wa, lru_ba, lru_wi, lru_bi,
                 lru_lambda, na_rpb, w_branch, w_out):
    b, s, _ = x.shape
    proj = jnp.einsum('bsd,dc->bsc', x, w_in)
    rq, rk, rv, rg, nq, nk, nv, lx, ly, gate_pre = split_columns(proj)
    ret = retention_branch(rq, rk, rv, rg, ret_decay)
    na = neighborhood_attention_branch(nq, nk, nv, na_rpb)
    lru = rglru_branch(lx, ly, w_conv, b_conv, lru_wa, lru_ba, lru_wi, lru_bi, lru_lambda)
    branches = jnp.stack([ret, na, lru], axis=2)
    up = jnp.einsum('bsni,nid->bsnd', branches, w_branch)
    gates = jax.nn.sigmoid(gate_pre + gate_b).reshape(b, s, N_BRANCH, D_MODEL)
    merged = jnp.sum(gates * up, axis=2)
    return jnp.einsum('bsd,de->bse', merged, w_out)


def swiglu(x, w_ffn_in, w_ffn_out):
    h = jnp.einsum('bsd,df->bsf', x, w_ffn_in)
    gate, val = h[..., :D_FF], h[..., D_FF:]
    return jnp.einsum('bsf,fd->bsd', jax.nn.silu(gate) * val, w_ffn_out)


def setup_inputs(seed: int = 0) -> dict:
    key = jax.random.key(seed)
    ks = jax.random.split(key, 22)
    nrm = lambda k, shape, scale: scale * jax.random.normal(k, shape, jnp.float32)
    gamma0 = 1.0 - 2.0 ** (-5.0 - jnp.arange(RET_HEADS, dtype=jnp.float32))
    decay_logit = jnp.log(gamma0) - jnp.log1p(-gamma0)
    a8 = jax.random.uniform(ks[12], (DEPTH, 2, LRU_WIDTH), jnp.float32, 0.9, 0.999)
    a = a8 ** (1.0 / LRU_C)
    return {
        'x': nrm(ks[0], (BATCH, SEQ, D_MODEL), 1.0),
        'ln_in_g': 1.0 + nrm(ks[1], (D_MODEL,), 0.02),
        'ln_in_b': nrm(ks[2], (D_MODEL,), 0.02),
        'w_in': nrm(ks[3], (DEPTH, D_MODEL, IN_COLS), D_MODEL ** -0.5),
        'gate_b': nrm(ks[4], (DEPTH, N_BRANCH * D_MODEL), 0.1),
        'ret_decay': decay_logit + nrm(ks[5], (DEPTH, 2, RET_HEADS), 0.05),
        'w_conv': nrm(ks[6], (DEPTH, LRU_CONV, LRU_WIDTH), LRU_CONV ** -0.5),
        'b_conv': nrm(ks[7], (DEPTH, LRU_WIDTH), 0.02),
        'lru_wa': nrm(ks[8], (DEPTH, 2, LRU_BLOCKS, LRU_BLOCK_DIM, LRU_BLOCK_DIM), LRU_BLOCK_DIM ** -0.5),
        'lru_ba': nrm(ks[9], (DEPTH, 2, LRU_WIDTH), 0.02),
        'lru_wi': nrm(ks[10], (DEPTH, 2, LRU_BLOCKS, LRU_BLOCK_DIM, LRU_BLOCK_DIM), LRU_BLOCK_DIM ** -0.5),
        'lru_bi': nrm(ks[11], (DEPTH, 2, LRU_WIDTH), 0.02),
        'lru_lambda': jnp.log(a) - jnp.log1p(-a),
        'na_rpb': nrm(ks[13], (DEPTH, NA_HEADS, 2 * NA_KH - 1, 2 * NA_KW - 1), 0.1),
        'w_branch': nrm(ks[14], (DEPTH, N_BRANCH, BRANCH_WIDTH, D_MODEL), BRANCH_WIDTH ** -0.5),
        'w_out': nrm(ks[15], (DEPTH, D_MODEL, D_MODEL), DEEPNORM_BETA * D_MODEL ** -0.5),
        'ln1_g': 1.0 + nrm(ks[16], (DEPTH, D_MODEL), 0.02),
        'ln1_b': nrm(ks[17], (DEPTH, D_MODEL), 0.02),
        'w_ffn_in': nrm(ks[18], (DEPTH, D_MODEL, 2 * D_FF), D_MODEL ** -0.5),
        'w_ffn_out': nrm(ks[19], (DEPTH, D_FF, D_MODEL), DEEPNORM_BETA * D_FF ** -0.5),
        'ln2_g': 1.0 + nrm(ks[20], (DEPTH, D_MODEL), 0.02),
        'ln2_b': nrm(ks[21], (DEPTH, D_MODEL), 0.02),
    }


def reference(x, ln_in_g, ln_in_b, w_in, gate_b, ret_decay, w_conv, b_conv, lru_wa, lru_ba,
              lru_wi, lru_bi, lru_lambda, na_rpb, w_branch, w_out, ln1_g, ln1_b,
              w_ffn_in, w_ffn_out, ln2_g, ln2_b):
    h = layer_norm(x, ln_in_g, ln_in_b)
    for l in range(DEPTH):
        mix = hybrid_mixer(h, w_in[l], gate_b[l], ret_decay[l], w_conv[l], b_conv[l],
                           lru_wa[l], lru_ba[l], lru_wi[l], lru_bi[l], lru_lambda[l],
                           na_rpb[l], w_branch[l], w_out[l])
        h = layer_norm(DEEPNORM_ALPHA * h + mix, ln1_g[l], ln1_b[l])
        h = layer_norm(DEEPNORM_ALPHA * h + swiglu(h, w_ffn_in[l], w_ffn_out[l]), ln2_g[l], ln2_b[l])
    return h
```

```cpp
#define MK_PER_PHASE 1
#include <hip/hip_runtime.h>
#include <cstdio>
#include <cstdint>
namespace pg8 {
#define PG8_LAS __attribute__((address_space(3)))
typedef unsigned short bf16_t;
typedef short bf16x8 __attribute__((ext_vector_type(8)));
typedef float f32x4 __attribute__((ext_vector_type(4)));
typedef unsigned u32x4 __attribute__((ext_vector_type(4)));
constexpr int BM = 256, BK = 64, HALF = 128, HTB = HALF * BK * 2  , STAGE_BYTES = 8 * HTB, NXCD = 8, WGM = 8;

__host__ __device__ __forceinline__ int lds_byte(int r, int c) { const int st = (r >> 4) * 2 + (c >> 5), rr = r & 15, cc = c & 31, ob = rr * 64 + cc * 2; return st * 1024 + (ob ^ (((ob >> 9) & 1) << 5)); }
__host__ __device__ __forceinline__ void stage_rc(int b, int& R, int& C) { const int st = b / 1024, sb = b % 1024, swz = sb ^ (((sb >> 9) & 1) << 5); R = (st >> 1) * 16 + swz / 64; C = (st & 1) * 32 + (swz % 64) / 2; }
__host__ __device__ __forceinline__ int perm32(int rho) { const int n = rho >> 4, i = rho & 15; return 8 * (i >> 2) + 4 * n + (i & 3); }

struct Unit { int pm, pn; };
struct Gemm { const bf16_t* A; const bf16_t* Bt; int M, N, K, lda, ldb; };

struct StaticOrder {
    int nM, nN, nwg, G, c;
    __host__ __device__ void init(int M, int N, int G_, int c_) { nM = M / BM; nN = N / BM; nwg = nM * nN; G = G_; c = c_; }
    __host__ __device__ bool next(int i, Unit& u) const {
        const long L = (long)i * G + c; if (L >= nwg) return false;
        int wgid = (int)L; { const int q = nwg / NXCD, r = nwg % NXCD, xcd = wgid % NXCD, off = wgid / NXCD; wgid = (xcd < r ? xcd * (q + 1) : r * (q + 1) + (xcd - r) * q) + off; }
        const int nig = WGM * nN, gid = wgid / nig, fm = gid * WGM, gsz = (nM - fm) < WGM ? (nM - fm) : WGM;
        u.pm = fm + ((wgid % nig) % gsz); u.pn = (wgid % nig) / gsz; return true;
    }
    __device__ __forceinline__ void a_ready(const Unit&) const {}
    __device__ __forceinline__ void done(const Unit&) const {}
};


__device__ __forceinline__ unsigned cvt_pk_bf16(float lo, float hi) { unsigned r; asm volatile("v_cvt_pk_bf16_f32 %0, %1, %2" : "=v"(r) : "v"(lo), "v"(hi)); return r; }
typedef unsigned u32x2 __attribute__((ext_vector_type(2)));
__device__ __forceinline__ float fsigmoid(float x) { return __builtin_amdgcn_rcpf(1.0f + __expf(-x)); }
__device__ __forceinline__ float fsilu(float x) { return x * fsigmoid(x); }
__device__ __forceinline__ float fgelu_tanh(float x) { const float u = 0.7978845608028654f * (x + 0.044715f * x * x * x); return x * fsigmoid(2.0f * u); }
__device__ __forceinline__ float bf_lo(unsigned w) { return __uint_as_float(w << 16); }
__device__ __forceinline__ float bf_hi(unsigned w) { return __uint_as_float(w & 0xffff0000u); }

constexpr int PROJ_LD = 15360;
struct EpiProj {
    static constexpr bool PERM = true, AFTER_DRAIN = false;
    bf16_t* O; const float* cs; const float* gate_b;
    __device__ __forceinline__ void operator()(const f32x4 (&acc)[2][2][4][2], const Unit& u, int wr, int wc, int fr, int fq) const {
        const int row0 = u.pm * BM + wr * 64 + fr, colb = u.pn * BM + wc * 32 + 8 * fq, kind = u.pn;
#pragma unroll
        for (int ai = 0; ai < 2; ++ai)
#pragma unroll
            for (int m = 0; m < 4; ++m) { const int row = row0 + ai * HALF + m * 16; bf16_t* rowp = O + (size_t)row * PROJ_LD + colb;
#pragma unroll
                for (int bj = 0; bj < 2; ++bj) { f32x4 v0 = acc[ai][bj][m][0], v1 = acc[ai][bj][m][1];
                    if (kind < 8) {
                        const int j0 = 64 * bj + 16 * wc + 4 * fq;
                        const f32x4 c01 = *(const f32x4*)(cs + ((size_t)row * 128 + j0) * 2), c23 = *(const f32x4*)(cs + ((size_t)row * 128 + j0 + 2) * 2);
                        const float sc = kind < 4 ? 1.0f : 0.0625f;
                        f32x4 o0, o1;
                        o0[0] = (v0[0] * c01[0] - v0[1] * c01[1]) * sc; o0[1] = (v0[0] * c01[1] + v0[1] * c01[0]) * sc;
                        o0[2] = (v0[2] * c01[2] - v0[3] * c01[3]) * sc; o0[3] = (v0[2] * c01[3] + v0[3] * c01[2]) * sc;
                        o1[0] = (v1[0] * c23[0] - v1[1] * c23[1]) * sc; o1[1] = (v1[0] * c23[1] + v1[1] * c23[0]) * sc;
                        o1[2] = (v1[2] * c23[2] - v1[3] * c23[3]) * sc; o1[3] = (v1[2] * c23[3] + v1[3] * c23[2]) * sc;
                        v0 = o0; v1 = o1;
                    } else if (kind >= 12 && kind < 16) {
#pragma unroll
                        for (int j = 0; j < 4; ++j) { v0[j] = fsilu(v0[j]); v1[j] = fsilu(v1[j]); }
                    } else if (kind >= 16 && kind < 20) {
                        v0 = v0 * 0.08838834764831845f; v1 = v1 * 0.08838834764831845f;
                    } else if (kind >= 32 && kind < 36) {
#pragma unroll
                        for (int j = 0; j < 4; ++j) { v0[j] = fgelu_tanh(v0[j]); v1[j] = fgelu_tanh(v1[j]); }
                    } else if (kind >= 36) {
                        const int gc = colb + bj * HALF - 9216;
                        const f32x4 b0 = *(const f32x4*)(gate_b + gc), b1 = *(const f32x4*)(gate_b + gc + 4);
#pragma unroll
                        for (int j = 0; j < 4; ++j) { v0[j] = fsigmoid(v0[j] + b0[j]); v1[j] = fsigmoid(v1[j] + b1[j]); }
                    }
                    u32x4 w; w.x = cvt_pk_bf16(v0[0], v0[1]); w.y = cvt_pk_bf16(v0[2], v0[3]); w.z = cvt_pk_bf16(v1[0], v1[1]); w.w = cvt_pk_bf16(v1[2], v1[3]);
                    *(u32x4*)(rowp + bj * HALF) = w; } }
    }
};
struct EpiRes {
    static constexpr bool PERM = false, AFTER_DRAIN = false;
    const float* H; float* Y; float alpha;
    __device__ __forceinline__ void operator()(const f32x4 (&acc)[2][2][4][2], const Unit& u, int wr, int wc, int fr, int fq) const {
        const int row0 = u.pm * BM + wr * 64 + fr, col0 = u.pn * BM + wc * 32 + 4 * fq;
#pragma unroll
        for (int ai = 0; ai < 2; ++ai)
#pragma unroll
            for (int m = 0; m < 4; ++m) { const size_t off = (size_t)(row0 + ai * HALF + m * 16) * 2048 + col0;
#pragma unroll
                for (int bj = 0; bj < 2; ++bj)
#pragma unroll
                    for (int n = 0; n < 2; ++n) { const f32x4 hv = *(const f32x4*)(H + off + bj * HALF + n * 16); *(f32x4*)(Y + off + bj * HALF + n * 16) = hv * alpha + acc[ai][bj][m][n]; }
                asm volatile("" ::: "memory"); }
    }
};
struct EpiSwiglu {
    static constexpr bool PERM = true, AFTER_DRAIN = false;
    bf16_t* O;
    __device__ __forceinline__ void operator()(const f32x4 (&acc)[2][2][4][2], const Unit& u, int wr, int wc, int fr, int fq) const {
        const int row0 = u.pm * BM + wr * 64 + fr, colb = (u.pn * BM + wc * 32 + 8 * fq) >> 1;
#pragma unroll
        for (int ai = 0; ai < 2; ++ai)
#pragma unroll
            for (int m = 0; m < 4; ++m) { bf16_t* rowp = O + (size_t)(row0 + ai * HALF + m * 16) * 5632 + colb;
#pragma unroll
                for (int bj = 0; bj < 2; ++bj) { const f32x4 g = acc[ai][bj][m][0], v = acc[ai][bj][m][1];
                    u32x2 w; w.x = cvt_pk_bf16(fsilu(g[0]) * v[0], fsilu(g[1]) * v[1]); w.y = cvt_pk_bf16(fsilu(g[2]) * v[2], fsilu(g[3]) * v[3]);
                    *(u32x2*)(rowp + bj * (HALF / 2)) = w; } }
    }
};
template <int PASS> struct EpiMerge {
    static constexpr bool PERM = true, AFTER_DRAIN = false;
    const bf16_t* G; float* Mf; bf16_t* Mb;
    __device__ __forceinline__ void operator()(const f32x4 (&acc)[2][2][4][2], const Unit& u, int wr, int wc, int fr, int fq) const {
        const int row0 = u.pm * BM + wr * 64 + fr, colb = u.pn * BM + wc * 32 + 8 * fq;
#pragma unroll
        for (int ai = 0; ai < 2; ++ai)
#pragma unroll
            for (int m = 0; m < 4; ++m) { const int row = row0 + ai * HALF + m * 16;
#pragma unroll
                for (int bj = 0; bj < 2; ++bj) { const int col = colb + bj * HALF;
                    const u32x4 gw = *(const u32x4*)(G + (size_t)row * PROJ_LD + col);
                    f32x4 g0, g1; g0[0] = bf_lo(gw.x); g0[1] = bf_hi(gw.x); g0[2] = bf_lo(gw.y); g0[3] = bf_hi(gw.y); g1[0] = bf_lo(gw.z); g1[1] = bf_hi(gw.z); g1[2] = bf_lo(gw.w); g1[3] = bf_hi(gw.w);
                    f32x4 m0 = g0 * acc[ai][bj][m][0], m1 = g1 * acc[ai][bj][m][1];
                    float* mp = Mf + (size_t)row * 2048 + col;
                    if (PASS > 0) { m0 = m0 + *(const f32x4*)mp; m1 = m1 + *(const f32x4*)(mp + 4); }
                    if (PASS < 2) { *(f32x4*)mp = m0; *(f32x4*)(mp + 4) = m1; }
                    else { u32x4 w; w.x = cvt_pk_bf16(m0[0], m0[1]); w.y = cvt_pk_bf16(m0[2], m0[3]); w.z = cvt_pk_bf16(m1[0], m1[1]); w.w = cvt_pk_bf16(m1[2], m1[3]);
                        *(u32x4*)(Mb + (size_t)row * 2048 + col) = w; } }
                asm volatile("" ::: "memory"); }
    }
};
template <class Epi, class Sched, bool ALIGN_EPI = false, bool SP2 = false>
__device__ __forceinline__ void gemm_phase(PG8_LAS unsigned char* lds, const Gemm g, const Sched& S, const Epi& E, int tid_in) {
    int tid_ = tid_in; asm volatile("" : "+v"(tid_)); const int tid = tid_, wid = __builtin_amdgcn_readfirstlane(tid >> 6), lane = tid & 63, wr = wid >> 2, wc = wid & 3, fr = lane & 15, fq = lane >> 4;
    const int K = g.K, nt = K / BK;
    unsigned voffA[2], voffB[2];
#pragma unroll
    for (int i = 0; i < 2; ++i) { int R, C; stage_rc(tid * 16 + i * 8192, R, C); const int Rb = Epi::PERM ? ((R & ~31) + perm32(R & 31)) : R;
        voffA[i] = (unsigned)(R * g.lda + C) * 2u; voffB[i] = (unsigned)(Rb * g.ldb + C) * 2u; }
    const size_t kstep = (size_t)(BK * 2);
    const size_t hstepA = (size_t)HALF * g.lda * 2, hstepB = (size_t)HALF * g.ldb * 2;
    const size_t tstepA = 2 * hstepA, tstepB = 2 * hstepB;
    const unsigned ldsw = (unsigned)wid * 1024u;
    const int aoff = lds_byte(wr * 64 + fr, fq * 8), boff = lds_byte(wc * 32 + fr, fq * 8);
#define PG8_SA(b, h) (((b) * 2 + (h)) * HTB)
#define PG8_SB(b, h) ((4 + (b) * 2 + (h)) * HTB)
#define PG8_STAGE(bufoff, gbase, voff) do { _Pragma("unroll") for (int _i = 0; _i < 2; ++_i) \
        __builtin_amdgcn_global_load_lds((const unsigned*)((const char*)(gbase) + (voff)[_i]), (PG8_LAS unsigned*)(lds + (bufoff) + ldsw + _i * 8192), 16, 0, 0); } while (0)
#define PG8_LDA(dst, b, h) do { _Pragma("unroll") for (int m = 0; m < 4; ++m) _Pragma("unroll") for (int k = 0; k < 2; ++k) dst[m][k] = *(const PG8_LAS bf16x8*)(lds + PG8_SA(b, h) + aoff + m * 2048 + k * 1024); } while (0)
#define PG8_LDB(dst, b, h) do { _Pragma("unroll") for (int n = 0; n < 2; ++n) _Pragma("unroll") for (int k = 0; k < 2; ++k) dst[n][k] = *(const PG8_LAS bf16x8*)(lds + PG8_SB(b, h) + boff + n * 2048 + k * 1024); } while (0)
#define PG8_MMA(ai, bj, At, Bt) do { __builtin_amdgcn_s_setprio(1); _Pragma("unroll") for (int m = 0; m < 4; ++m) _Pragma("unroll") for (int n = 0; n < 2; ++n) _Pragma("unroll") for (int k = 0; k < 2; ++k) \
        acc[ai][bj][m][n] = __builtin_amdgcn_mfma_f32_16x16x32_bf16(Bt[n][k], At[m][k], acc[ai][bj][m][n], 0, 0, 0); __builtin_amdgcn_s_setprio(0); } while (0)
#define PG8_WAIT_V(n) asm volatile("s_waitcnt vmcnt(" #n ")" ::: "memory")
#define PG8_WAIT_L(n) asm volatile("s_waitcnt lgkmcnt(" #n ")" ::: "memory")
#define PG8_BAR __builtin_amdgcn_s_barrier()
#define PG8_SCHED __builtin_amdgcn_sched_barrier(0)
    Unit cur, nxt; int ui = 0;
    if (!S.next(0, cur)) return;
    f32x4 acc[2][2][4][2];
#pragma unroll
    for (int a = 0; a < 2; ++a)
#pragma unroll
        for (int b = 0; b < 2; ++b)
#pragma unroll
            for (int m = 0; m < 4; ++m)
#pragma unroll
                for (int n = 0; n < 2; ++n) acc[a][b][m][n] = (f32x4){0.f, 0.f, 0.f, 0.f};
    bf16x8 At[4][2], B0[2][2], B1[2][2];
    const char* cA = (const char*)g.A + (size_t)cur.pm * tstepA; const char* cB = (const char*)g.Bt + (size_t)cur.pn * tstepB;
    S.a_ready(cur);
    if constexpr (SP2) {
        PG8_STAGE(PG8_SB(0, 0), cB, voffB); PG8_STAGE(PG8_SB(0, 1), cB + hstepB, voffB); PG8_STAGE(PG8_SA(0, 0), cA, voffA); PG8_STAGE(PG8_SA(0, 1), cA + hstepA, voffA);
        if (wr == 1) PG8_BAR;
        PG8_WAIT_V(2); PG8_BAR;
        PG8_STAGE(PG8_SB(1, 0), cB + kstep, voffB); PG8_STAGE(PG8_SA(1, 0), cA + kstep, voffA); PG8_STAGE(PG8_SB(1, 1), cB + hstepB + kstep, voffB);
        PG8_WAIT_V(6); PG8_BAR;
    } else {
        PG8_STAGE(PG8_SB(0, 0), cB, voffB); PG8_STAGE(PG8_SA(0, 0), cA, voffA); PG8_STAGE(PG8_SB(0, 1), cB + hstepB, voffB); PG8_STAGE(PG8_SA(0, 1), cA + hstepA, voffA);
        if (wr == 1) PG8_BAR;
        PG8_WAIT_V(4); PG8_BAR;
        PG8_STAGE(PG8_SB(1, 0), cB + kstep, voffB); PG8_STAGE(PG8_SA(1, 0), cA + kstep, voffA); PG8_STAGE(PG8_SB(1, 1), cB + hstepB + kstep, voffB);
        PG8_WAIT_V(6); PG8_BAR;
    }
    for (;;) {
        const bool has_next = S.next(ui + 1, nxt);
        const char* nA = has_next ? (const char*)g.A + (size_t)nxt.pm * tstepA : cA; const char* nB = has_next ? (const char*)g.Bt + (size_t)nxt.pn * tstepB : cB;
        for (int t = 0; t < nt; t += 2) {
            const bool last = (t == nt - 2);
            const char* a1 = cA + (size_t)(t + 1) * kstep;
            const char* a2 = last ? nA : cA + (size_t)(t + 2) * kstep; const char* b2 = last ? nB : cB + (size_t)(t + 2) * kstep;
            const char* a3 = a2 + kstep; const char* b3 = b2 + kstep;
            if (last && has_next) S.a_ready(nxt);
            if constexpr (SP2) {
            PG8_LDB(B0, 0, 0); PG8_LDB(B1, 0, 1); PG8_SCHED; PG8_LDA(At, 0, 0); PG8_STAGE(PG8_SA(1, 1), a1 + hstepA, voffA);
            PG8_WAIT_V(8); PG8_WAIT_L(0); PG8_BAR; PG8_MMA(0, 0, At, B0); PG8_MMA(0, 1, At, B1); PG8_BAR; PG8_SCHED;
            PG8_LDA(At, 0, 1); PG8_STAGE(PG8_SB(0, 0), b2, voffB); PG8_STAGE(PG8_SB(0, 1), b2 + hstepB, voffB); PG8_STAGE(PG8_SA(0, 0), a2, voffA);
            PG8_WAIT_V(8); PG8_WAIT_L(0); PG8_BAR; PG8_MMA(1, 0, At, B0); PG8_MMA(1, 1, At, B1); PG8_BAR; PG8_SCHED;
            PG8_LDB(B0, 1, 0); PG8_LDB(B1, 1, 1); PG8_SCHED; PG8_LDA(At, 1, 0); PG8_STAGE(PG8_SA(0, 1), a2 + hstepA, voffA);
            PG8_WAIT_V(8); PG8_WAIT_L(0); PG8_BAR; PG8_MMA(0, 0, At, B0); PG8_MMA(0, 1, At, B1); PG8_BAR; PG8_SCHED;
            PG8_LDA(At, 1, 1); PG8_STAGE(PG8_SB(1, 0), b3, voffB); PG8_STAGE(PG8_SB(1, 1), b3 + hstepB, voffB); PG8_STAGE(PG8_SA(1, 0), a3, voffA);
            PG8_WAIT_V(8); PG8_WAIT_L(0); PG8_BAR; PG8_MMA(1, 0, At, B0); PG8_MMA(1, 1, At, B1); PG8_BAR; PG8_SCHED;
            } else {
            PG8_LDB(B0, 0, 0); PG8_SCHED; PG8_LDA(At, 0, 0); PG8_STAGE(PG8_SA(1, 1), a1 + hstepA, voffA);
            PG8_WAIT_L(8); PG8_BAR; PG8_WAIT_L(0); PG8_MMA(0, 0, At, B0); PG8_BAR; PG8_SCHED;
            PG8_LDB(B1, 0, 1); PG8_STAGE(PG8_SB(0, 0), b2, voffB);
            PG8_BAR; PG8_WAIT_L(0); PG8_MMA(0, 1, At, B1); PG8_BAR;
            PG8_LDA(At, 0, 1); PG8_STAGE(PG8_SA(0, 0), a2, voffA);
            PG8_BAR; PG8_WAIT_L(0); PG8_MMA(1, 0, At, B0); PG8_BAR; PG8_SCHED;
            PG8_STAGE(PG8_SB(0, 1), b2 + hstepB, voffB);
            PG8_WAIT_V(6); PG8_BAR; PG8_MMA(1, 1, At, B1); PG8_BAR;
            PG8_LDB(B0, 1, 0); PG8_SCHED; PG8_LDA(At, 1, 0); PG8_STAGE(PG8_SA(0, 1), a2 + hstepA, voffA);
            PG8_WAIT_L(8); PG8_BAR; PG8_WAIT_L(0); PG8_MMA(0, 0, At, B0); PG8_BAR; PG8_SCHED;
            PG8_LDB(B1, 1, 1); PG8_STAGE(PG8_SB(1, 0), b3, voffB);
            PG8_BAR; PG8_WAIT_L(0); PG8_MMA(0, 1, At, B1); PG8_BAR;
            PG8_LDA(At, 1, 1); PG8_STAGE(PG8_SA(1, 0), a3, voffA);
            PG8_BAR; PG8_WAIT_L(0); PG8_MMA(1, 0, At, B0); PG8_BAR; PG8_SCHED;
            PG8_STAGE(PG8_SB(1, 1), b3 + hstepB, voffB);
            PG8_WAIT_V(6); PG8_BAR; PG8_MMA(1, 1, At, B1); PG8_BAR;
            }
        }
        if constexpr (ALIGN_EPI) { if (wr == 0) PG8_BAR; }
        if constexpr (!Epi::AFTER_DRAIN) { E(acc, cur, wr, wc, fr, fq); S.done(cur); }
        if (!has_next) break;
#pragma unroll
        for (int a = 0; a < 2; ++a)
#pragma unroll
            for (int b = 0; b < 2; ++b)
#pragma unroll
                for (int m = 0; m < 4; ++m)
#pragma unroll
                    for (int n = 0; n < 2; ++n) acc[a][b][m][n] = (f32x4){0.f, 0.f, 0.f, 0.f};
        cur = nxt; cA = nA; cB = nB; ++ui;
        if constexpr (ALIGN_EPI) { if (wr == 1) PG8_BAR; }
    }
    PG8_WAIT_V(0);
    if constexpr (!ALIGN_EPI) { if (wr == 0) PG8_BAR; }
    PG8_BAR;
    if constexpr (Epi::AFTER_DRAIN) { E.fused(acc, cur, wr, wc, fr, fq, lds, wid, lane); S.done(cur); }
#undef PG8_SA
#undef PG8_SB
#undef PG8_STAGE
#undef PG8_LDA
#undef PG8_LDB
#undef PG8_MMA
#undef PG8_WAIT_V
#undef PG8_WAIT_L
#undef PG8_BAR
#undef PG8_SCHED
}
}
#define LAS __attribute__((address_space(3)))
#define XB_TMO      128
#define XB_XCNT(j)  (256  + 64 * (j))
#define XB_XSUB(j)  (1280 + 64 * (j))
#define XB_XGEN(j)  (2304 + 64 * (j))
#define XB_TOP      3328
#define XB_TOPGEN   3392
#define XCD_BAR_WORDS 3456
#define XB_SPIN_CAP (1u << 18)

__device__ __forceinline__ unsigned xb_ld(unsigned* p)              { return __hip_atomic_load(p, __ATOMIC_RELAXED, __HIP_MEMORY_SCOPE_AGENT); }
__device__ __forceinline__ unsigned xb_add(unsigned* p, unsigned v) { return __hip_atomic_fetch_add(p, v, __ATOMIC_RELAXED, __HIP_MEMORY_SCOPE_AGENT); }
__device__ __forceinline__ unsigned xb_xcc_id() { return (unsigned)__builtin_amdgcn_s_getreg((3 << 11) | 20) & 0xFu; }
#define XB_SPIN(cond, bar) do { unsigned _sp = 0; while (cond) { __builtin_amdgcn_s_sleep(1); \
    if ((++_sp & 255u) == 0u) { if (xb_ld(&(bar)[XB_TMO])) break; if (_sp > XB_SPIN_CAP) { atomicAdd(&(bar)[XB_TMO], 1u); break; } } } } while (0)

struct XcdBarrier {
    unsigned* bar; unsigned x;
    volatile LAS unsigned* st;
};

__device__ __forceinline__ XcdBarrier xcd_barrier_post(unsigned* bar, volatile LAS unsigned* st) {
    XcdBarrier b; b.bar = bar; b.x = xb_xcc_id(); b.st = st;
    if (threadIdx.x == 0) (void)xb_add(&bar[XB_XCNT(b.x)], 1u);
    return b;
}
__device__ __forceinline__ void xcd_barrier_complete(unsigned* bar, unsigned x, unsigned& nloc, unsigned& nx) {
    const unsigned G = gridDim.x * gridDim.y * gridDim.z;
    unsigned sum, cnt, mine, sp = 0u;
    for (;;) {
        sum = 0u; cnt = 0u; mine = 0u;
#pragma unroll
        for (unsigned j = 0; j < 16; ++j) { const unsigned c = xb_ld(&bar[XB_XCNT(j)]); sum += c; cnt += (c > 0u) ? 1u : 0u; mine = (j == x) ? c : mine; }
        if (sum == G) break;
        __builtin_amdgcn_s_sleep(1);
        if ((++sp & 255u) == 0u) { if (xb_ld(&bar[XB_TMO])) break; if (sp > XB_SPIN_CAP) { atomicAdd(&bar[XB_TMO], 1u); break; } }
    }
    nloc = mine > 0u ? mine : 1u; nx = cnt > 0u ? cnt : 1u;
}

__device__ __forceinline__ void xcd_barrier(const XcdBarrier& b, const int tid_x) {
    asm volatile("s_waitcnt vmcnt(0)" ::: "memory");
    __syncthreads();
    if (tid_x == 0) {
        unsigned* bar = b.bar;
        __builtin_amdgcn_s_waitcnt(0);
        unsigned nloc = b.st[0], nx = b.st[1];
        if (nloc == 0u) { xcd_barrier_complete(bar, b.x, nloc, nx); b.st[0] = nloc; b.st[1] = nx; }
        const unsigned old = xb_add(&bar[XB_XSUB(b.x)], 1u);
        const unsigned gen = old / nloc;
        if (old + 1u == (gen + 1u) * nloc) {
            __builtin_amdgcn_fence(__ATOMIC_RELEASE, "agent");
            asm volatile("s_waitcnt vmcnt(0)" ::: "memory");
            const unsigned og = xb_add(&bar[XB_TOP], 1u);
            const unsigned tg = og / nx;
            if (og + 1u == (tg + 1u) * nx) xb_add(&bar[XB_TOPGEN], 1u);
            else XB_SPIN(xb_ld(&bar[XB_TOPGEN]) == tg, bar);
            __builtin_amdgcn_fence(__ATOMIC_ACQUIRE, "agent");
            xb_add(&bar[XB_XGEN(b.x)], 1u);
            asm volatile("s_waitcnt vmcnt(0)" ::: "memory");
        } else {
            XB_SPIN(xb_ld(&bar[XB_XGEN(b.x)]) == gen, bar);
            __builtin_amdgcn_fence(__ATOMIC_ACQUIRE, "agent");
            asm volatile("s_waitcnt vmcnt(0)" ::: "memory");
        }
    }
    __syncthreads();
}
__device__ const float INVF[128] = { 1.000000000e+00f, 9.305720329e-01f, 8.659643531e-01f, 8.058421612e-01f, 7.498942614e-01f, 6.978306174e-01f, 6.493816376e-01f, 6.042963862e-01f, 5.623413324e-01f, 5.232990980e-01f, 4.869675338e-01f, 4.531583786e-01f, 4.216965139e-01f, 3.924189806e-01f, 3.651741147e-01f, 3.398208320e-01f, 3.162277639e-01f, 2.942726910e-01f, 2.738419771e-01f, 2.548296750e-01f, 2.371373773e-01f, 2.206734121e-01f, 2.053525001e-01f, 1.910953075e-01f, 1.778279394e-01f, 1.654817164e-01f, 1.539926529e-01f, 1.433012486e-01f, 1.333521307e-01f, 1.240937784e-01f, 1.154782027e-01f, 1.074607819e-01f, 1.000000015e-01f, 9.305720776e-02f, 8.659642935e-02f, 8.058421314e-02f, 7.498941571e-02f, 6.978306174e-02f, 6.493816525e-02f, 6.042964011e-02f, 5.623413250e-02f, 5.232991278e-02f, 4.869675264e-02f, 4.531583562e-02f, 4.216965288e-02f, 3.924189508e-02f, 3.651741147e-02f, 3.398208320e-02f, 3.162277490e-02f, 2.942727134e-02f, 2.738419734e-02f, 2.548296750e-02f, 2.371373773e-02f, 2.206734009e-02f, 2.053525113e-02f, 1.910952851e-02f, 1.778279431e-02f, 1.654816978e-02f, 1.539926510e-02f, 1.433012541e-02f, 1.333521493e-02f, 1.240937784e-02f, 1.154782064e-02f, 1.074607857e-02f, 9.999999776e-03f, 9.305720218e-03f, 8.659643121e-03f, 8.058422245e-03f, 7.498941850e-03f, 6.978305988e-03f, 6.493816152e-03f, 6.042963825e-03f, 5.623413250e-03f, 5.232991185e-03f, 4.869675264e-03f, 4.531583283e-03f, 4.216964822e-03f, 3.924189601e-03f, 3.651741194e-03f, 3.398208413e-03f, 3.162277630e-03f, 2.942727180e-03f, 2.738419687e-03f, 2.548296936e-03f, 2.371373586e-03f, 2.206734149e-03f, 2.053524833e-03f, 1.910952968e-03f, 1.778279431e-03f, 1.654817141e-03f, 1.539926510e-03f, 1.433012541e-03f, 1.333521446e-03f, 1.240937738e-03f, 1.154781901e-03f, 1.074607833e-03f, 1.000000047e-03f, 9.305720450e-04f, 8.659643354e-04f, 8.058421663e-04f, 7.498942432e-04f, 6.978305755e-04f, 6.493816618e-04f, 6.042963942e-04f, 5.623413017e-04f, 5.232990952e-04f, 4.869675322e-04f, 4.531583691e-04f, 4.216965172e-04f, 3.924189659e-04f, 3.651741426e-04f, 3.398208355e-04f, 3.162277571e-04f, 2.942727006e-04f, 2.738419571e-04f, 2.548296761e-04f, 2.371373703e-04f, 2.206734061e-04f, 2.053525095e-04f, 1.910952997e-04f, 1.778279402e-04f, 1.654817170e-04f, 1.539926452e-04f, 1.433012512e-04f, 1.333521504e-04f, 1.240937709e-04f, 1.154782003e-04f, 1.074607862e-04f };

#ifndef PG8_SP2
#define PG8_SP2 true
#endif
#ifndef PG8_ALIGN
#define PG8_ALIGN true
#endif
#ifndef MK_PER_PHASE
#define MK_PER_PHASE 1
#endif

constexpr int SEQ = 8192, DM = 2048, INC = 15360, DFF = 5632, DEPTH = 4, NWAVES = 8, NTHR = 512;
constexpr float LN_EPS = 1e-5f, DN_ALPHA = 1.681792830507429f;
constexpr int C_RQ = 0, C_RK = 1024, C_RV = 2048, C_RG = 3072, C_NQ = 4096, C_NK = 5120, C_NV = 6144, C_LX = 7168, C_LY = 8192, C_GATE = 9216;
constexpr int N_PHASES = 1 + 10 * DEPTH;
constexpr size_t MiB = 1u << 20;
constexpr size_t SZ_WIN = (size_t)INC * DM * 2, SZ_WBR = (size_t)3 * DM * 1024 * 2, SZ_WOUT = (size_t)DM * DM * 2, SZ_WFI = (size_t)2 * DFF * DM * 2, SZ_WFO = (size_t)DM * DFF * 2;
constexpr size_t LO_WIN = 0, LO_WBR = LO_WIN + SZ_WIN, LO_WOUT = LO_WBR + SZ_WBR, LO_WFI = LO_WOUT + SZ_WOUT, LO_WFO = LO_WFI + SZ_WFI, LAYER_W = LO_WFO + SZ_WFO;
constexpr size_t LRUW_LAYER = (size_t)2 * 2 * 8 * 16384;
constexpr size_t WS_CTL = 0, CTL_ZERO_BYTES = 1 * MiB;
constexpr size_t WS_W = 1 * MiB;
constexpr size_t WS_LRUW = WS_W + DEPTH * LAYER_W;
constexpr size_t WS_CS = WS_LRUW + DEPTH * LRUW_LAYER * 2;
constexpr size_t WS_H = WS_CS + 8 * MiB;
constexpr size_t WS_HB = WS_H + 64 * MiB;
constexpr size_t WS_Y = WS_HB + 32 * MiB;
constexpr size_t WS_P = WS_Y + 64 * MiB;
constexpr size_t WS_BR = WS_P + 240 * MiB;
constexpr size_t WS_MF = WS_BR + 48 * MiB;
constexpr size_t WS_MB = WS_MF + 64 * MiB;
constexpr size_t WS_ACT = WS_MB + 32 * MiB;
constexpr size_t WS_KV = WS_ACT + 88 * MiB;
constexpr size_t WS_PREV = WS_KV + 128 * MiB;
constexpr size_t WS_LH = WS_PREV + 64 * MiB;
constexpr size_t WS_LSUM = WS_LH + 128 * MiB;
constexpr size_t WS_LCAR = WS_LSUM + 2 * MiB;
constexpr size_t WS_END = WS_LCAR + 1 * MiB;
static_assert(WS_LRUW % 256 == 0 && WS_CS % 256 == 0 && LAYER_W % 256 == 0, "alignment");
constexpr int CW_BAR = 4096;
constexpr int RING_BYTES = 131072, MISC_OFF = RING_BYTES + 12288, LDS_BYTES = 147456;


typedef unsigned short bf16;
typedef unsigned u32x4 __attribute__((ext_vector_type(4)));
typedef unsigned u32x2 __attribute__((ext_vector_type(2)));
typedef float f32x4 __attribute__((ext_vector_type(4)));
typedef float f32x2 __attribute__((ext_vector_type(2)));
typedef short bf16x8 __attribute__((ext_vector_type(8)));
typedef short v4i16_t __attribute__((ext_vector_type(4)));
__device__ __forceinline__ int lane_id_v() { int l; asm volatile("v_mbcnt_lo_u32_b32 %0, -1, 0\n\tv_mbcnt_hi_u32_b32 %0, -1, %0" : "=v"(l)); return l; }
#define LDS_WAIT() asm volatile("s_waitcnt lgkmcnt(0)" ::: "memory")

__device__ __forceinline__ unsigned pk2(float lo, float hi) { return pg8::cvt_pk_bf16(lo, hi); }
__device__ __forceinline__ float bflo(unsigned w) { return __uint_as_float(w << 16); }
__device__ __forceinline__ float bfhi(unsigned w) { return __uint_as_float(w & 0xffff0000u); }
__device__ __forceinline__ float bf1(unsigned short b) { return __uint_as_float(((unsigned)b) << 16); }
__device__ __forceinline__ float log1p_pos(float y) { const float z = y / (2.0f + y), z2 = z * z;
    const float ser = 2.0f * z * (1.0f + z2 * (0.33333334f + z2 * (0.2f + z2 * (0.14285715f + z2 * 0.11111111f))));
    return y < 0.25f ? ser : __logf(1.0f + y); }
__device__ __forceinline__ float neg_expm1(float x) { const float p = -x * (1.0f + x * (0.5f + x * (0.16666667f + x * (0.041666668f + x * (0.008333334f + x * 0.0013888889f)))));
    return x > -0.5f ? p : 1.0f - __expf(x); }
__device__ __forceinline__ float softplus(float x) { return fmaxf(x, 0.f) + log1p_pos(__expf(-fabsf(x))); }
__device__ __forceinline__ float log_sigmoid(float x) { return -softplus(-x); }
__device__ __forceinline__ f32x4 mfma16(bf16x8 a, bf16x8 b, f32x4 c) { return __builtin_amdgcn_mfma_f32_16x16x32_bf16(a, b, c, 0, 0, 0); }
__device__ __forceinline__ bf16x8 ldrow(const LAS unsigned char* base, int RS, int r0, int k0, int lane) {
    return *(const LAS bf16x8*)(base + (r0 + (lane & 15)) * RS + (k0 + 8 * (lane >> 4)) * 2);
}
__device__ __forceinline__ bf16x8 ldtr(const LAS unsigned char* base, int RS, int k0, int c0, int lane) {
    const int g = lane >> 4, i = lane & 15, q = i >> 2, p = i & 3;
    const LAS unsigned char* a = base + (k0 + 8 * g + q) * RS + (c0 + 4 * p) * 2;
    const v4i16_t lo = __builtin_amdgcn_ds_read_tr16_b64_v4i16((LAS v4i16_t*)a);
    const v4i16_t hi = __builtin_amdgcn_ds_read_tr16_b64_v4i16((LAS v4i16_t*)(a + 4 * RS));
    return (bf16x8){lo[0], lo[1], lo[2], lo[3], hi[0], hi[1], hi[2], hi[3]};
}
__device__ __forceinline__ float shx(float v, int o, int lane) { return __int_as_float(__builtin_amdgcn_ds_bpermute((lane ^ o) << 2, __float_as_int(v))); }
__device__ __forceinline__ float wave_sum(float v, int lane) {
#pragma unroll
    for (int o = 1; o < 64; o <<= 1) v += shx(v, o, lane);
    return v;
}

template <int PK> __device__ __forceinline__ int dst_row(int n) {
    if (PK == 1) { if (n < 2048) { const int j = n & 255, b = n - j; return b + (j < 128 ? 2 * j : 2 * (j - 128) + 1); } return n; }
    if (PK == 2) { if (n < DFF) return 8 * (n >> 2) + (n & 3); const int v = n - DFF; return 8 * (v >> 2) + 4 + (v & 3); }
    return n;
}
template <int PK> __device__ __forceinline__ void transpose_item(const float* W, int K, int N, bf16* WT, LAS float* scr, int item, int lane) {
    const int nblk = N / 32, kb = item / nblk, nb = item % nblk, k0 = 64 * kb, n0 = 32 * nb;
#pragma unroll 8
    for (int i = 0; i < 32; ++i) { const int kk = 2 * i + (lane >> 5); scr[kk * 33 + (lane & 31)] = W[(size_t)(k0 + kk) * N + n0 + (lane & 31)]; }
    LDS_WAIT(); asm volatile("" ::: "memory");
    const int c = lane & 7;
#pragma unroll
    for (int j = 0; j < 4; ++j) { const int n = (lane >> 3) + 8 * j; const LAS float* s = scr + (8 * c) * 33 + n;
        u32x4 o; o.x = pk2(s[0 * 33], s[1 * 33]); o.y = pk2(s[2 * 33], s[3 * 33]); o.z = pk2(s[4 * 33], s[5 * 33]); o.w = pk2(s[6 * 33], s[7 * 33]);
        *(u32x4*)(WT + (size_t)dst_row<PK>(n0 + n) * K + k0 + 8 * c) = o; }
    LDS_WAIT(); asm volatile("" ::: "memory");
}
__device__ __forceinline__ void ln_row(const float* yrow, const float* gam, const float* bet, float* hrow, bf16* hbrow, float* orow, int lane) {
    const f32x4* yr = (const f32x4*)yrow + lane;
    f32x4 v[8]; float s = 0.f;
#pragma unroll
    for (int j = 0; j < 8; ++j) { v[j] = yr[64 * j]; s += (v[j][0] + v[j][1]) + (v[j][2] + v[j][3]); }
    const float mean = wave_sum(s, lane) * (1.f / DM); float s2 = 0.f;
#pragma unroll
    for (int j = 0; j < 8; ++j) { v[j] = v[j] - mean; s2 += (v[j][0] * v[j][0] + v[j][1] * v[j][1]) + (v[j][2] * v[j][2] + v[j][3] * v[j][3]); }
    const float rstd = 1.f / sqrtf(wave_sum(s2, lane) * (1.f / DM) + LN_EPS);
#pragma unroll
    for (int j = 0; j < 8; ++j) { const f32x4 g = ((const f32x4*)gam)[lane + 64 * j], b = ((const f32x4*)bet)[lane + 64 * j];
        const f32x4 o = v[j] * rstd * g + b;
        ((f32x4*)hrow)[lane + 64 * j] = o; if (orow) ((f32x4*)orow)[lane + 64 * j] = o;
        u32x2 w; w.x = pk2(o[0], o[1]); w.y = pk2(o[2], o[3]); ((u32x2*)hbrow)[lane + 64 * j] = w; }
}
__device__ __forceinline__ void cs_entry(int pos, int j, float* out2) {
    const float angf = (float)pos * INVF[j];
    const double t = (double)angf * 0.15915494309189533577;
    double fr = t - floor(t);
    const double k = rint(fr * 4.0); const double r = fr - k * 0.25;
    const double x = r * 6.28318530717958647693, x2 = x * x;
    const double sn = x * (1.0 + x2 * (-1.0 / 6 + x2 * (1.0 / 120 + x2 * (-1.0 / 5040 + x2 * (1.0 / 362880 + x2 * (-1.0 / 39916800))))));
    const double cn = 1.0 + x2 * (-0.5 + x2 * (1.0 / 24 + x2 * (-1.0 / 720 + x2 * (1.0 / 40320 + x2 * (-1.0 / 3628800 + x2 * (1.0 / 479001600))))));
    const int q = ((int)k) & 3;
    double c, s;
    if (q == 0) { c = cn; s = sn; } else if (q == 1) { c = -sn; s = cn; } else if (q == 2) { c = -cn; s = -sn; } else { c = sn; s = -cn; }
    out2[0] = (float)c; out2[1] = (float)s;
}

__device__ __forceinline__ void stage_tile(LAS unsigned char* dst, int RS, const bf16* src, size_t ld, int rows, int c8n, int tid) {
    for (int idx = tid; idx < rows * c8n; idx += NTHR) { const int r = idx / c8n, c8 = idx - r * c8n;
        *(LAS u32x4*)(dst + r * RS + c8 * 16) = *(const u32x4*)(src + (size_t)r * ld + c8 * 8); }
}

__device__ __forceinline__ void ret_kv_unit(LAS unsigned char* lds, const bf16* P, float* KV, const float* dec, int u, int tid) {
    asm volatile("" : "+v"(tid));
    const int h = u & 3, n = u >> 2, lane = tid & 63, w = tid >> 6, g = lane >> 4, i = lane & 15;
    const size_t t0 = (size_t)n * 128;
    constexpr int RSK = 528, RSV = 272;
    LAS unsigned char* Kt = lds; LAS unsigned char* Vf = lds + 67584; LAS unsigned char* Vb = Vf + 34816;
    const float lgf = log_sigmoid(dec[h]), lgb = log_sigmoid(dec[4 + h]);
    stage_tile(Kt, RSK, P + t0 * INC + C_RK + h * 256, INC, 128, 32, tid);
    for (int eh = 0; eh < 2; ++eh) {
        if (eh) __syncthreads();
        for (int idx = tid; idx < 128 * 16; idx += NTHR) { const int r = idx >> 4, c8 = idx & 15;
            const u32x4 v = *(const u32x4*)(P + (t0 + r) * INC + C_RV + h * 256 + eh * 128 + c8 * 8);
            const float sf = __expf((float)(127 - r) * lgf), sb = __expf((float)r * lgb);
            u32x4 of, ob;
            of.x = pk2(bflo(v.x) * sf, bfhi(v.x) * sf); of.y = pk2(bflo(v.y) * sf, bfhi(v.y) * sf); of.z = pk2(bflo(v.z) * sf, bfhi(v.z) * sf); of.w = pk2(bflo(v.w) * sf, bfhi(v.w) * sf);
            ob.x = pk2(bflo(v.x) * sb, bfhi(v.x) * sb); ob.y = pk2(bflo(v.y) * sb, bfhi(v.y) * sb); ob.z = pk2(bflo(v.z) * sb, bfhi(v.z) * sb); ob.w = pk2(bflo(v.w) * sb, bfhi(v.w) * sb);
            *(LAS u32x4*)(Vf + r * RSV + c8 * 16) = of; *(LAS u32x4*)(Vb + r * RSV + c8 * 16) = ob; }
        __syncthreads();
        for (int dir = 0; dir < 2; ++dir) {
            const LAS unsigned char* Vd = dir ? Vb : Vf;
            f32x4 acc[8][2];
#pragma unroll
            for (int mt = 0; mt < 8; ++mt) { acc[mt][0] = (f32x4){0.f, 0.f, 0.f, 0.f}; acc[mt][1] = (f32x4){0.f, 0.f, 0.f, 0.f}; }
#pragma unroll
            for (int ks = 0; ks < 4; ++ks) {
                const bf16x8 kf0 = ldtr(Kt, RSK, 32 * ks, 32 * w, lane), kf1 = ldtr(Kt, RSK, 32 * ks, 32 * w + 16, lane);
#pragma unroll
                for (int mt = 0; mt < 8; ++mt) { const bf16x8 vf = ldtr(Vd, RSV, 32 * ks, 16 * mt, lane); acc[mt][0] = mfma16(vf, kf0, acc[mt][0]); acc[mt][1] = mfma16(vf, kf1, acc[mt][1]); }
            }
            float* dst = KV + ((size_t)n * 8 + h * 2 + dir) * 65536;
#pragma unroll
            for (int mt = 0; mt < 8; ++mt)
#pragma unroll
                for (int nt = 0; nt < 2; ++nt)
#pragma unroll
                    for (int r = 0; r < 4; ++r) dst[(eh * 128 + 16 * mt + 4 * g + r) * 256 + 32 * w + 16 * nt + i] = acc[mt][nt][r];
        }
    }
    __syncthreads();
}

__device__ __forceinline__ void ret_apply_unit(LAS unsigned char* lds, const bf16* P, const bf16* PREV, bf16* BR, const float* dec, int u, int tid) {
    asm volatile("" : "+v"(tid));
    const int h = u & 3, n = u >> 2, lane = tid & 63, w = tid >> 6, g = lane >> 4, i = lane & 15;
    const size_t t0 = (size_t)n * 128;
    constexpr int RSQ = 528, RSP = 272, RSC = 144;
    LAS unsigned char* Qt = lds; LAS unsigned char* R2 = lds + 67584;
    LAS unsigned char* Kt = R2; LAS unsigned char* Pl = R2; LAS unsigned char* Vh = R2 + 34816; LAS unsigned char* Pc = R2;
    const float lgf2 = log_sigmoid(dec[h]) * 1.4426950408889634f, lgb2 = log_sigmoid(dec[4 + h]) * 1.4426950408889634f;
    stage_tile(Qt, RSQ, P + t0 * INC + C_RQ + h * 256, INC, 128, 32, tid);
    stage_tile(Kt, RSQ, P + t0 * INC + C_RK + h * 256, INC, 128, 32, tid);
    __syncthreads();
    f32x4 s[8];
#pragma unroll
    for (int mt = 0; mt < 8; ++mt) s[mt] = (f32x4){0.f, 0.f, 0.f, 0.f};
#pragma unroll
    for (int ks = 0; ks < 8; ++ks) { const bf16x8 qf = ldrow(Qt, RSQ, 16 * w, 32 * ks, lane);
#pragma unroll
        for (int mt = 0; mt < 8; ++mt) { const bf16x8 kf = ldrow(Kt, RSQ, 16 * mt, 32 * ks, lane); s[mt] = mfma16(kf, qf, s[mt]); } }
    __syncthreads();
    const int a = 16 * w + i;
#pragma unroll
    for (int mt = 0; mt < 8; ++mt) { float p[4];
#pragma unroll
        for (int r = 0; r < 4; ++r) { const int b = 16 * mt + 4 * g + r, df = a - b; const float D = df >= 0 ? exp2f((float)df * lgf2) : exp2f((float)(-df) * lgb2); p[r] = s[mt][r] * D; }
        u32x2 wv; wv.x = pk2(p[0], p[1]); wv.y = pk2(p[2], p[3]);
        *(LAS u32x2*)(Pl + a * RSP + (16 * mt + 4 * g) * 2) = wv; }
    f32x4 acc[16];
#pragma unroll
    for (int mt = 0; mt < 16; ++mt) acc[mt] = (f32x4){0.f, 0.f, 0.f, 0.f};
#pragma unroll
    for (int eh = 0; eh < 2; ++eh) {
        stage_tile(Vh, RSP, P + t0 * INC + C_RV + h * 256 + eh * 128, INC, 128, 16, tid);
        __syncthreads();
#pragma unroll
        for (int ks = 0; ks < 4; ++ks) { const bf16x8 pf = ldrow(Pl, RSP, 16 * w, 32 * ks, lane);
#pragma unroll
            for (int mt = 0; mt < 8; ++mt) { const bf16x8 vf = ldtr(Vh, RSP, 32 * ks, 16 * mt, lane); acc[8 * eh + mt] = mfma16(vf, pf, acc[8 * eh + mt]); } }
        __syncthreads();
    }
#pragma unroll
    for (int dir = 0; dir < 2; ++dir) {
        const bf16* pv = PREV + ((size_t)n * 8 + h * 2 + dir) * 65536;
        const float qd = dir == 0 ? exp2f((float)(a + 1) * lgf2) : exp2f((float)(128 - a) * lgb2);
#pragma unroll
        for (int eh = 0; eh < 2; ++eh) {
            f32x4 X[8];
#pragma unroll
            for (int mt = 0; mt < 8; ++mt) X[mt] = (f32x4){0.f, 0.f, 0.f, 0.f};
            for (int dc = 0; dc < 4; ++dc) {
                stage_tile(Pc, RSC, pv + (size_t)eh * 128 * 256 + dc * 64, 256, 128, 8, tid);
                __syncthreads();
#pragma unroll
                for (int ks = 0; ks < 2; ++ks) { const bf16x8 qf = ldrow(Qt, RSQ, 16 * w, 64 * dc + 32 * ks, lane);
#pragma unroll
                    for (int mt = 0; mt < 8; ++mt) { const bf16x8 pf = ldrow(Pc, RSC, 16 * mt, 32 * ks, lane); X[mt] = mfma16(pf, qf, X[mt]); } }
                __syncthreads();
            }
#pragma unroll
            for (int mt = 0; mt < 8; ++mt) acc[8 * eh + mt] = acc[8 * eh + mt] + X[mt] * qd;
        }
    }
    float sm = 0.f;
#pragma unroll
    for (int mt = 0; mt < 16; ++mt) sm += (acc[mt][0] + acc[mt][1]) + (acc[mt][2] + acc[mt][3]);
    sm += shx(sm, 16, lane); sm += shx(sm, 32, lane);
    const float mean = sm * (1.f / 256.f); float sq = 0.f;
#pragma unroll
    for (int mt = 0; mt < 16; ++mt) { const f32x4 d = acc[mt] - mean; sq += (d[0] * d[0] + d[1] * d[1]) + (d[2] * d[2] + d[3] * d[3]); }
    sq += shx(sq, 16, lane); sq += shx(sq, 32, lane);
    const float rstd = 1.f / sqrtf(sq * (1.f / 256.f) + LN_EPS);
    const size_t tok = t0 + a;
#pragma unroll
    for (int mt = 0; mt < 16; ++mt) { const int e = 16 * mt + 4 * g;
        const u32x2 gw = *(const u32x2*)(P + tok * INC + C_RG + h * 256 + e);
        const f32x4 d = (acc[mt] - mean) * rstd;
        u32x2 o; o.x = pk2(d[0] * bflo(gw.x), d[1] * bfhi(gw.x)); o.y = pk2(d[2] * bflo(gw.y), d[3] * bfhi(gw.y));
        *(u32x2*)(BR + tok * 3072 + h * 256 + e) = o; }
    __syncthreads();
}

__device__ __forceinline__ void na_unit(LAS unsigned char* lds, const bf16* P, const float* rpb, bf16* BR, int u, int tid) {
    asm volatile("" : "+v"(tid));
    const int hd = u & 7, rp = u >> 3, lane = tid & 63, w = tid >> 6, half = w >> 2, j = w & 3, g = lane >> 4, i = lane & 15;
    const int r = 2 * rp + half, rs = min(max(r - 4, 0), 120);
    const int ks0 = j == 0 ? 0 : (j == 1 ? 8 : (j == 2 ? 24 : 32));
    constexpr int RS = 272, RSP = 528;
    LAS unsigned char* Qt = lds; LAS unsigned char* KVt = lds + 34816; LAS unsigned char* Psc = lds + 69632 + w * 8448; LAS float* rpbs = (LAS float*)(lds + 137216);
    for (int idx = tid; idx < 2 * 64 * 16; idx += NTHR) { const int hh = idx >> 10, rr = (idx >> 4) & 63, c8 = idx & 15;
        *(LAS u32x4*)(Qt + hh * 17408 + rr * RS + c8 * 16) = *(const u32x4*)(P + ((size_t)(2 * rp + hh) * 64 + rr) * INC + C_NQ + hd * 128 + c8 * 8); }
    for (int idx = tid; idx < 465; idx += NTHR) rpbs[idx] = rpb[hd * 465 + idx];
    __syncthreads();
    bf16x8 qf[4];
#pragma unroll
    for (int ks = 0; ks < 4; ++ks) qf[ks] = ldrow(Qt + half * 17408, RS, 16 * j, 32 * ks, lane);
    f32x4 s[8][2];
#pragma unroll
    for (int kr = 0; kr < 8; ++kr) { s[kr][0] = (f32x4){0.f, 0.f, 0.f, 0.f}; s[kr][1] = (f32x4){0.f, 0.f, 0.f, 0.f}; }
#pragma unroll
    for (int kr = 0; kr < 8; ++kr) {
        for (int idx = tid; idx < 2 * 64 * 16; idx += NTHR) { const int hh = idx >> 10, rr = (idx >> 4) & 63, c8 = idx & 15; const int rsh = min(max(2 * rp + hh - 4, 0), 120);
            *(LAS u32x4*)(KVt + hh * 17408 + rr * RS + c8 * 16) = *(const u32x4*)(P + ((size_t)(rsh + kr) * 64 + rr) * INC + C_NK + hd * 128 + c8 * 8); }
        __syncthreads();
#pragma unroll
        for (int mt = 0; mt < 2; ++mt)
#pragma unroll
            for (int ks = 0; ks < 4; ++ks) { const bf16x8 kf = ldrow(KVt + half * 17408, RS, ks0 + 16 * mt, 32 * ks, lane); s[kr][mt] = mfma16(kf, qf[ks], s[kr][mt]); }
        __syncthreads();
    }
    const int cq = 16 * j + i, cst = min(max(cq - 8, 0), 48);
    float mx = -1e30f;
#pragma unroll
    for (int kr = 0; kr < 8; ++kr)
#pragma unroll
        for (int mt = 0; mt < 2; ++mt)
#pragma unroll
            for (int q = 0; q < 4; ++q) { const int ck = ks0 + 16 * mt + 4 * g + q; const bool ok = ck >= cst && ck < cst + 16;
                const int dcl = min(max(ck - cq + 15, 0), 30);
                const float v = ok ? s[kr][mt][q] + rpbs[(rs + kr - r + 7) * 31 + dcl] : -1e30f; s[kr][mt][q] = v; mx = fmaxf(mx, v); }
    mx = fmaxf(mx, shx(mx, 16, lane)); mx = fmaxf(mx, shx(mx, 32, lane));
    float sum = 0.f;
#pragma unroll
    for (int kr = 0; kr < 8; ++kr)
#pragma unroll
        for (int mt = 0; mt < 2; ++mt)
#pragma unroll
            for (int q = 0; q < 4; ++q) { const float v = s[kr][mt][q]; const float p = v > -1e29f ? __expf(v - mx) : 0.f; s[kr][mt][q] = p; sum += p; }
    sum += shx(sum, 16, lane); sum += shx(sum, 32, lane);
    const float inv = 1.f / sum;
#pragma unroll
    for (int kr = 0; kr < 8; ++kr)
#pragma unroll
        for (int mt = 0; mt < 2; ++mt) { u32x2 wv; wv.x = pk2(s[kr][mt][0] * inv, s[kr][mt][1] * inv); wv.y = pk2(s[kr][mt][2] * inv, s[kr][mt][3] * inv);
            *(LAS u32x2*)(Psc + i * RSP + (kr * 32 + 16 * mt + 4 * g) * 2) = wv; }
    f32x4 o[8];
#pragma unroll
    for (int mt = 0; mt < 8; ++mt) o[mt] = (f32x4){0.f, 0.f, 0.f, 0.f};
#pragma unroll
    for (int kr = 0; kr < 8; ++kr) {
        for (int idx = tid; idx < 2 * 64 * 16; idx += NTHR) { const int hh = idx >> 10, rr = (idx >> 4) & 63, c8 = idx & 15; const int rsh = min(max(2 * rp + hh - 4, 0), 120);
            *(LAS u32x4*)(KVt + hh * 17408 + rr * RS + c8 * 16) = *(const u32x4*)(P + ((size_t)(rsh + kr) * 64 + rr) * INC + C_NV + hd * 128 + c8 * 8); }
        __syncthreads();
        const bf16x8 pf = ldrow(Psc, RSP, 0, 32 * kr, lane);
#pragma unroll
        for (int mt = 0; mt < 8; ++mt) { const bf16x8 vf = ldtr(KVt + half * 17408, RS, ks0, 16 * mt, lane); o[mt] = mfma16(vf, pf, o[mt]); }
        __syncthreads();
    }
    const size_t tok = (size_t)r * 64 + cq;
#pragma unroll
    for (int mt = 0; mt < 8; ++mt) { u32x2 wv; wv.x = pk2(o[mt][0], o[mt][1]); wv.y = pk2(o[mt][2], o[mt][3]);
        *(u32x2*)(BR + tok * 3072 + 1024 + hd * 128 + 16 * mt + 4 * g) = wv; }
}

__device__ __forceinline__ void lru_unit(LAS unsigned char* lds, const bf16* P, const bf16* LW, const float* wconv, const float* bconv, const float* ba, const float* bi, const float* lam,
                                         float* LH, float* LSUM, int u, int tid) {
    asm volatile("" : "+v"(tid));
    const int nb = u & 7, tc = u >> 3, lane = tid & 63, w = tid >> 6, g = lane >> 4, i = lane & 15;
    const int t0 = 64 * tc, c0 = 128 * nb;
    LAS unsigned char* Xr = lds; LAS unsigned char* XC = lds + 17408; LAS unsigned char* XB = lds + 51200; LAS unsigned char* AL = lds + 68608; LAS unsigned char* IL = lds + 102400;
    for (int idx = tid; idx < 67 * 16; idx += NTHR) { const int rr = idx >> 4, c8 = idx & 15; const int tok = t0 - 2 + rr;
        u32x4 v = (u32x4){0u, 0u, 0u, 0u};
        if (tok >= 0 && tok < SEQ) v = *(const u32x4*)(P + (size_t)tok * INC + C_LX + c0 + c8 * 8);
        *(LAS u32x4*)(Xr + rr * 256 + c8 * 16) = v; }
    __syncthreads();
    { const int c = tid & 127, tq = tid >> 7;
      const float w0 = wconv[c0 + c], w1 = wconv[1024 + c0 + c], w2 = wconv[2048 + c0 + c], w3 = wconv[3072 + c0 + c], bb = bconv[c0 + c];
      for (int tt = 0; tt < 16; ++tt) { const int t = tq * 16 + tt;
          const float x0 = bf1(*(const LAS bf16*)(Xr + (t + 0) * 256 + c * 2)), x1 = bf1(*(const LAS bf16*)(Xr + (t + 1) * 256 + c * 2)),
                      x2 = bf1(*(const LAS bf16*)(Xr + (t + 2) * 256 + c * 2)), x3 = bf1(*(const LAS bf16*)(Xr + (t + 3) * 256 + c * 2));
          const float xc = ((w0 * x0 + w1 * x1) + (w2 * x2 + w3 * x3)) + bb;
          *(LAS float*)(XC + t * 528 + c * 4) = xc; *(LAS bf16*)(XB + t * 272 + c * 2) = (bf16)(pk2(xc, 0.f) & 0xffffu); } }
    __syncthreads();
    for (int dir = 0; dir < 2; ++dir) {
        f32x4 ga[4], gi[4];
#pragma unroll
        for (int nt = 0; nt < 4; ++nt) { ga[nt] = (f32x4){0.f, 0.f, 0.f, 0.f}; gi[nt] = (f32x4){0.f, 0.f, 0.f, 0.f}; }
        const bf16* WA = LW + ((size_t)(0 * 2 + dir) * 8 + nb) * 16384; const bf16* WI = LW + ((size_t)(1 * 2 + dir) * 8 + nb) * 16384;
#pragma unroll
        for (int ks = 0; ks < 4; ++ks) {
            const bf16x8 af = *(const bf16x8*)(WA + (16 * w + i) * 128 + 32 * ks + 8 * g), bfr = *(const bf16x8*)(WI + (16 * w + i) * 128 + 32 * ks + 8 * g);
#pragma unroll
            for (int nt = 0; nt < 4; ++nt) { const bf16x8 xf = ldrow(XB, 272, 16 * nt, 32 * ks, lane); ga[nt] = mfma16(af, xf, ga[nt]); gi[nt] = mfma16(bfr, xf, gi[nt]); }
        }
        const int cl = 16 * w + 4 * g, cg = dir * 1024 + c0 + cl;
        const f32x4 bav = *(const f32x4*)(ba + cg), biv = *(const f32x4*)(bi + cg), lmv = *(const f32x4*)(lam + cg);
        f32x4 sp;
#pragma unroll
        for (int q = 0; q < 4; ++q) sp[q] = softplus(-lmv[q]);
#pragma unroll
        for (int nt = 0; nt < 4; ++nt) { const int t = 16 * nt + i;
            const f32x4 xc4 = *(const LAS f32x4*)(XC + t * 528 + cl * 4);
            f32x4 av, iv;
#pragma unroll
            for (int q = 0; q < 4; ++q) { const float rg = pg8::fsigmoid(ga[nt][q] + bav[q]), ig = pg8::fsigmoid(gi[nt][q] + biv[q]);
                const float la = -8.0f * rg * sp[q]; av[q] = __expf(la); iv[q] = sqrtf(fmaxf(neg_expm1(2.0f * la), 0.f)) * (ig * xc4[q]); }
            *(LAS f32x4*)(AL + t * 528 + cl * 4) = av; *(LAS f32x4*)(IL + t * 528 + cl * 4) = iv; }
        __syncthreads();
        if (tid < 128) { const int c = tid; float hh = 0.f, pp = 1.f;
            float* Hd = LH + (size_t)(2 * dir) * SEQ * 1024; float* Pd = LH + (size_t)(2 * dir + 1) * SEQ * 1024;
            for (int st = 0; st < 64; ++st) { const int t = dir ? 63 - st : st;
                const float av = *(const LAS float*)(AL + t * 528 + c * 4), xv = *(const LAS float*)(IL + t * 528 + c * 4);
                hh = av * hh + xv; pp *= av;
                Hd[(size_t)(t0 + t) * 1024 + c0 + c] = hh; Pd[(size_t)(t0 + t) * 1024 + c0 + c] = pp; }
            LSUM[((size_t)(dir * 128 + tc) * 2 + 0) * 1024 + c0 + c] = pp; LSUM[((size_t)(dir * 128 + tc) * 2 + 1) * 1024 + c0 + c] = hh; }
        __syncthreads();
    }
}

struct Args { const float* in[22]; float* out; unsigned char* ws; int ph_lo, ph_hi; };
enum { I_X = 0, I_LNIN_G, I_LNIN_B, I_WIN, I_GATEB, I_RETDEC, I_WCONV, I_BCONV, I_LRUWA, I_LRUBA, I_LRUWI, I_LRUBI, I_LRULAM, I_RPB, I_WBR, I_WOUT, I_LN1G, I_LN1B, I_WFI, I_WFO, I_LN2G, I_LN2B };

__global__ void __launch_bounds__(NTHR, 2) fwd(Args args) {
    extern __shared__ __attribute__((aligned(16))) unsigned char lds_raw[];
    LAS unsigned char* lds = (LAS unsigned char*)lds_raw;
    volatile LAS unsigned* MISC = (volatile LAS unsigned*)(lds + MISC_OFF);
    const int G = gridDim.x, bx = blockIdx.x, wave_s = __builtin_amdgcn_readfirstlane(threadIdx.x >> 6);
    unsigned char* ws = args.ws;
    unsigned* ctl = (unsigned*)(ws + WS_CTL);
    const int lo = args.ph_lo, hi = args.ph_hi;
    for (int u = threadIdx.x; u < (LDS_BYTES - MISC_OFF) / 4; u += NTHR) ((LAS unsigned*)(lds + MISC_OFF))[u] = 0u;
    __syncthreads();
    XcdBarrier bar; bar.bar = ctl + CW_BAR; bar.x = 0; bar.st = nullptr;
    if (hi - lo > 1) bar = xcd_barrier_post(ctl + CW_BAR, MISC + 8);
#ifndef PHMASK
#define PHMASK 0x7ff
#endif
#define IN(k) (lo <= (k) && (k) < hi)
#define EN(b) ((PHMASK >> (b)) & 1)
#define SEAM(k) do { if ((k) + 1 < hi) { XcdBarrier b2_ = bar; asm volatile("" : "+s"(b2_.bar)); xcd_barrier(b2_, wave_s * 64 + lane_id_v()); } } while (0)

#define PTRS() unsigned char* wsp = ws; asm volatile("" : "+s"(wsp)); const int tid = wave_s * 64 + lane_id_v(); \
    const int lane = tid & 63, wave = __builtin_amdgcn_readfirstlane(tid >> 6), gw = bx * NWAVES + wave, NGW = G * NWAVES, gt = bx * NTHR + tid, NGT = G * NTHR; (void)lane; (void)gw; (void)NGW; (void)gt; (void)NGT; \
    bf16* HB = (bf16*)(wsp + WS_HB); float* H = (float*)(wsp + WS_H); float* Y = (float*)(wsp + WS_Y); \
    bf16* P = (bf16*)(wsp + WS_P); bf16* BR = (bf16*)(wsp + WS_BR); float* MF = (float*)(wsp + WS_MF); bf16* MB = (bf16*)(wsp + WS_MB); bf16* ACT = (bf16*)(wsp + WS_ACT); \
    float* KV = (float*)(wsp + WS_KV); bf16* PREV = (bf16*)(wsp + WS_PREV); float* LH = (float*)(wsp + WS_LH); float* LSUM = (float*)(wsp + WS_LSUM); float* LCAR = (float*)(wsp + WS_LCAR); \
    float* CS = (float*)(wsp + WS_CS); const unsigned char* wl = wsp + WS_W + (size_t)l * LAYER_W; const float* dec = args.in[I_RETDEC] + l * 8; \
    (void)HB; (void)H; (void)Y; (void)P; (void)BR; (void)MF; (void)MB; (void)ACT; (void)KV; (void)PREV; (void)LH; (void)LSUM; (void)LCAR; (void)CS; (void)wl; (void)dec;

    if (EN(10) && IN(0)) {
        const int l = 0; PTRS();
        LAS float* scr = (LAS float*)(lds + wave * 16384);
        constexpr int I_IN = (DM / 64) * (INC / 32), I_BR1 = (1024 / 64) * (DM / 32), I_OUT = (DM / 64) * (DM / 32), I_FI = (DM / 64) * (2 * DFF / 32), I_FO = (DFF / 64) * (DM / 32);
        constexpr int PER_LAYER = I_IN + 3 * I_BR1 + I_OUT + I_FI + I_FO;
        for (int it = gw; it < DEPTH * PER_LAYER; it += NGW) {
            const int l = it / PER_LAYER; int r = it - l * PER_LAYER;
            unsigned char* wl2 = wsp + WS_W + (size_t)l * LAYER_W;
            if (r < I_IN) { transpose_item<1>(args.in[I_WIN] + (size_t)l * DM * INC, DM, INC, (bf16*)(wl2 + LO_WIN), scr, r, lane); continue; } r -= I_IN;
            if (r < 3 * I_BR1) { const int nbr = r / I_BR1; transpose_item<0>(args.in[I_WBR] + ((size_t)l * 3 + nbr) * 1024 * DM, 1024, DM, (bf16*)(wl2 + LO_WBR) + (size_t)nbr * DM * 1024, scr, r - nbr * I_BR1, lane); continue; } r -= 3 * I_BR1;
            if (r < I_OUT) { transpose_item<0>(args.in[I_WOUT] + (size_t)l * DM * DM, DM, DM, (bf16*)(wl2 + LO_WOUT), scr, r, lane); continue; } r -= I_OUT;
            if (r < I_FI) { transpose_item<2>(args.in[I_WFI] + (size_t)l * DM * 2 * DFF, DM, 2 * DFF, (bf16*)(wl2 + LO_WFI), scr, r, lane); continue; } r -= I_FI;
            transpose_item<0>(args.in[I_WFO] + (size_t)l * DFF * DM, DFF, DM, (bf16*)(wl2 + LO_WFO), scr, r, lane);
        }
        for (int it = gw; it < DEPTH * 2 * 2 * 8 * 8; it += NGW) {
            const int item = it & 7, m = it >> 3, nb = m & 7, dir = (m >> 3) & 1, kind = (m >> 4) & 1, l = m >> 5;
            const float* src = (kind ? args.in[I_LRUWI] : args.in[I_LRUWA]) + ((size_t)(l * 2 + dir) * 8 + nb) * 16384;
            bf16* dst = (bf16*)(wsp + WS_LRUW) + (size_t)l * LRUW_LAYER + ((size_t)(kind * 2 + dir) * 8 + nb) * 16384;
            transpose_item<0>(src, 128, 128, dst, scr, item, lane);
        }
        for (int e = gt; e < SEQ * 128; e += NGT) cs_entry(e >> 7, e & 127, CS + (size_t)e * 2);
        for (int m = gw; m < SEQ; m += NGW) ln_row(args.in[I_X] + (size_t)m * DM, args.in[I_LNIN_G], args.in[I_LNIN_B], H + (size_t)m * DM, HB + (size_t)m * DM, nullptr, lane);
        SEAM(0);
    }

    for (int l = 0; l < DEPTH; ++l) {
        const int pb = 1 + 10 * l;
        if (EN(0) && IN(pb + 0)) {
            PTRS();
            pg8::Gemm g{HB, (const bf16*)(wl + LO_WIN), SEQ, INC, DM, DM, DM}; pg8::StaticOrder S; S.init(SEQ, INC, G, bx);
            pg8::EpiProj E{P, CS, args.in[I_GATEB] + (size_t)l * 6144};
            pg8::gemm_phase<pg8::EpiProj, pg8::StaticOrder, PG8_ALIGN, PG8_SP2>(lds, g, S, E, tid);
            SEAM(pb + 0);
        }
        if (EN(1) && IN(pb + 1)) {
            PTRS();
            for (int u = bx; u < 256; u += G) ret_kv_unit(lds, P, KV, dec, u, tid);
            const bf16* LW = (const bf16*)(wsp + WS_LRUW) + (size_t)l * LRUW_LAYER;
            for (int u = bx; u < 1024; u += G)
                lru_unit(lds, P, LW, args.in[I_WCONV] + (size_t)l * 4096, args.in[I_BCONV] + (size_t)l * 1024, args.in[I_LRUBA] + (size_t)l * 2048, args.in[I_LRUBI] + (size_t)l * 2048,
                         args.in[I_LRULAM] + (size_t)l * 2048, LH, LSUM, u, tid);
            for (int u = bx; u < 512; u += G) na_unit(lds, P, args.in[I_RPB] + (size_t)l * 8 * 465, BR, u, tid);
            SEAM(pb + 1);
        }
        if (EN(2) && IN(pb + 2)) {
            PTRS();
            for (int q = gt; q < 131072; q += NGT) {
                const int hd = q >> 14, h = hd >> 1, dir = hd & 1, qq = q & 16383;
                const float c = __expf(128.0f * log_sigmoid(dec[dir * 4 + h]));
                f32x4 s = (f32x4){0.f, 0.f, 0.f, 0.f};
                for (int st = 0; st < 64; ++st) { const int n = dir ? 63 - st : st; const size_t o = ((size_t)n * 8 + hd) * 16384 + qq;
                    u32x2 wv; wv.x = pk2(s[0], s[1]); wv.y = pk2(s[2], s[3]); ((u32x2*)PREV)[o] = wv;
                    const f32x4 kv = ((const f32x4*)KV)[o]; s = s * c + kv; }
            }
            for (int q = gt; q < 2048; q += NGT) { const int dir = q >> 10, c = q & 1023; float cin = 0.f;
                for (int st = 0; st < 128; ++st) { const int tc = dir ? 127 - st : st; const size_t o = (size_t)(dir * 128 + tc);
                    LCAR[o * 1024 + c] = cin; cin = LSUM[(o * 2 + 0) * 1024 + c] * cin + LSUM[(o * 2 + 1) * 1024 + c]; } }
            SEAM(pb + 2);
        }
        if (EN(3) && IN(pb + 3)) {
            PTRS();
            for (int u = bx; u < 256; u += G) ret_apply_unit(lds, P, PREV, BR, dec, u, tid);
            for (int q = gt; q < SEQ * 256; q += NGT) { const int tok = q >> 8, c = (q & 255) * 4, tc = tok >> 6; const size_t o = (size_t)tok * 1024 + c;
                const f32x4 hf = *(const f32x4*)(LH + o), pf = *(const f32x4*)(LH + (size_t)SEQ * 1024 + o), hb = *(const f32x4*)(LH + (size_t)2 * SEQ * 1024 + o), pbk = *(const f32x4*)(LH + (size_t)3 * SEQ * 1024 + o);
                const f32x4 cf = *(const f32x4*)(LCAR + (size_t)tc * 1024 + c), cb = *(const f32x4*)(LCAR + (size_t)(128 + tc) * 1024 + c);
                const u32x2 yw = *(const u32x2*)(P + (size_t)tok * INC + C_LY + c);
                const f32x4 hv = (hf + pf * cf) + (hb + pbk * cb);
                u32x2 ov; ov.x = pk2(hv[0] * bflo(yw.x), hv[1] * bfhi(yw.x)); ov.y = pk2(hv[2] * bflo(yw.y), hv[3] * bfhi(yw.y));
                *(u32x2*)(BR + (size_t)tok * 3072 + 2048 + c) = ov; }
            SEAM(pb + 3);
        }
        if (EN(4) && IN(pb + 4)) {
            PTRS();
            pg8::StaticOrder S; S.init(SEQ, DM, G, bx);
            { pg8::Gemm g{BR, (const bf16*)(wl + LO_WBR), SEQ, DM, 1024, 3072, 1024}; pg8::EpiMerge<0> E{P + C_GATE, MF, MB};
              pg8::gemm_phase<pg8::EpiMerge<0>, pg8::StaticOrder, PG8_ALIGN, PG8_SP2>(lds, g, S, E, tid); }
            { pg8::Gemm g{BR + 1024, (const bf16*)(wl + LO_WBR) + (size_t)DM * 1024, SEQ, DM, 1024, 3072, 1024}; pg8::EpiMerge<1> E{P + C_GATE + 2048, MF, MB};
              pg8::gemm_phase<pg8::EpiMerge<1>, pg8::StaticOrder, PG8_ALIGN, PG8_SP2>(lds, g, S, E, tid); }
            { pg8::Gemm g{BR + 2048, (const bf16*)(wl + LO_WBR) + (size_t)2 * DM * 1024, SEQ, DM, 1024, 3072, 1024}; pg8::EpiMerge<2> E{P + C_GATE + 4096, MF, MB};
              pg8::gemm_phase<pg8::EpiMerge<2>, pg8::StaticOrder, PG8_ALIGN, PG8_SP2>(lds, g, S, E, tid); }
            SEAM(pb + 4);
        }
        if (EN(5) && IN(pb + 5)) {
            PTRS();
            pg8::Gemm g{MB, (const bf16*)(wl + LO_WOUT), SEQ, DM, DM, DM, DM}; pg8::StaticOrder S; S.init(SEQ, DM, G, bx);
            pg8::EpiRes E{H, Y, DN_ALPHA};
            pg8::gemm_phase<pg8::EpiRes, pg8::StaticOrder, PG8_ALIGN, PG8_SP2>(lds, g, S, E, tid);
            SEAM(pb + 5);
        }
        if (EN(6) && IN(pb + 6)) {
            PTRS();
            for (int m = gw; m < SEQ; m += NGW) ln_row(Y + (size_t)m * DM, args.in[I_LN1G] + (size_t)l * DM, args.in[I_LN1B] + (size_t)l * DM, H + (size_t)m * DM, HB + (size_t)m * DM, nullptr, lane);
            SEAM(pb + 6);
        }
        if (EN(7) && IN(pb + 7)) {
            PTRS();
            pg8::Gemm g{HB, (const bf16*)(wl + LO_WFI), SEQ, 2 * DFF, DM, DM, DM}; pg8::StaticOrder S; S.init(SEQ, 2 * DFF, G, bx);
            pg8::EpiSwiglu E{ACT};
            pg8::gemm_phase<pg8::EpiSwiglu, pg8::StaticOrder, PG8_ALIGN, PG8_SP2>(lds, g, S, E, tid);
            SEAM(pb + 7);
        }
        if (EN(8) && IN(pb + 8)) {
            PTRS();
            pg8::Gemm g{ACT, (const bf16*)(wl + LO_WFO), SEQ, DM, DFF, DFF, DFF}; pg8::StaticOrder S; S.init(SEQ, DM, G, bx);
            pg8::EpiRes E{H, Y, DN_ALPHA};
            pg8::gemm_phase<pg8::EpiRes, pg8::StaticOrder, PG8_ALIGN, PG8_SP2>(lds, g, S, E, tid);
            SEAM(pb + 8);
        }
        if (EN(9) && IN(pb + 9)) {
            PTRS();
            float* outp = (l == DEPTH - 1) ? args.out : nullptr;
            for (int m = gw; m < SEQ; m += NGW) ln_row(Y + (size_t)m * DM, args.in[I_LN2G] + (size_t)l * DM, args.in[I_LN2B] + (size_t)l * DM, H + (size_t)m * DM, HB + (size_t)m * DM, outp ? outp + (size_t)m * DM : nullptr, lane);
            SEAM(pb + 9);
        }
    }
#undef IN
#undef SEAM
}

extern "C" void kernel_launch(void* const* d_in, const int* in_sizes, int n_in, void* d_out, int out_size, void* d_ws, size_t ws_size, hipStream_t stream) {
    static int grid = 0;
    if (grid == 0) {
        if (n_in != 22 || out_size != SEQ * DM || ws_size < WS_END) { fprintf(stderr, "kernel_launch: unexpected shapes: n_in %d out %d ws %zu (need %zu)\n", n_in, out_size, ws_size, (size_t)WS_END); grid = -1; return; }
        int dev = 0, cus = 0, per_cu = 0;
        if (hipGetDevice(&dev) != hipSuccess || hipDeviceGetAttribute(&cus, hipDeviceAttributeMultiprocessorCount, dev) != hipSuccess) { grid = -1; return; }
        if (hipFuncSetAttribute((const void*)fwd, hipFuncAttributeMaxDynamicSharedMemorySize, LDS_BYTES) != hipSuccess) { fprintf(stderr, "kernel_launch: hipFuncSetAttribute failed\n"); grid = -1; return; }
        if (hipOccupancyMaxActiveBlocksPerMultiprocessor(&per_cu, (const void*)fwd, NTHR, LDS_BYTES) != hipSuccess || per_cu < 1) fprintf(stderr, "kernel_launch: occupancy query says %d\n", per_cu);
        (void)hipGetLastError();
        grid = cus;
    }
    if (grid < 0) return;
    if (hipMemsetAsync((char*)d_ws + WS_CTL, 0, CTL_ZERO_BYTES, stream) != hipSuccess) return;
    Args a{};
    for (int i = 0; i < 22; ++i) a.in[i] = (const float*)d_in[i];
    a.out = (float*)d_out; a.ws = (unsigned char*)d_ws;
#if MK_PER_PHASE
    for (int p = 0; p < N_PHASES; ++p) { a.ph_lo = p; a.ph_hi = p + 1; hipLaunchKernelGGL(fwd, dim3(grid), dim3(NTHR), LDS_BYTES, stream, a); }
#else
    a.ph_lo = 0; a.ph_hi = N_PHASES; hipLaunchKernelGGL(fwd, dim3(grid), dim3(NTHR), LDS_BYTES, stream, a);
#endif
}
```

```cpp
#define MK_PER_PHASE 0
#include <hip/hip_runtime.h>
#include <cstdio>
#include <cstdint>
namespace pg8 {
#define PG8_LAS __attribute__((address_space(3)))
typedef unsigned short bf16_t;
typedef short bf16x8 __attribute__((ext_vector_type(8)));
typedef float f32x4 __attribute__((ext_vector_type(4)));
typedef unsigned u32x4 __attribute__((ext_vector_type(4)));
constexpr int BM = 256, BK = 64, HALF = 128, HTB = HALF * BK * 2  , STAGE_BYTES = 8 * HTB, NXCD = 8, WGM = 8;

__host__ __device__ __forceinline__ int lds_byte(int r, int c) { const int st = (r >> 4) * 2 + (c >> 5), rr = r & 15, cc = c & 31, ob = rr * 64 + cc * 2; return st * 1024 + (ob ^ (((ob >> 9) & 1) << 5)); }
__host__ __device__ __forceinline__ void stage_rc(int b, int& R, int& C) { const int st = b / 1024, sb = b % 1024, swz = sb ^ (((sb >> 9) & 1) << 5); R = (st >> 1) * 16 + swz / 64; C = (st & 1) * 32 + (swz % 64) / 2; }
__host__ __device__ __forceinline__ int perm32(int rho) { const int n = rho >> 4, i = rho & 15; return 8 * (i >> 2) + 4 * n + (i & 3); }

struct Unit { int pm, pn; };
struct Gemm { const bf16_t* A; const bf16_t* Bt; int M, N, K, lda, ldb; };

struct StaticOrder {
    int nM, nN, nwg, G, c;
    __host__ __device__ void init(int M, int N, int G_, int c_) { nM = M / BM; nN = N / BM; nwg = nM * nN; G = G_; c = c_; }
    __host__ __device__ bool next(int i, Unit& u) const {
        const long L = (long)i * G + c; if (L >= nwg) return false;
        int wgid = (int)L; { const int q = nwg / NXCD, r = nwg % NXCD, xcd = wgid % NXCD, off = wgid / NXCD; wgid = (xcd < r ? xcd * (q + 1) : r * (q + 1) + (xcd - r) * q) + off; }
        const int nig = WGM * nN, gid = wgid / nig, fm = gid * WGM, gsz = (nM - fm) < WGM ? (nM - fm) : WGM;
        u.pm = fm + ((wgid % nig) % gsz); u.pn = (wgid % nig) / gsz; return true;
    }
    __device__ __forceinline__ void a_ready(const Unit&) const {}
    __device__ __forceinline__ void done(const Unit&) const {}
};


__device__ __forceinline__ unsigned cvt_pk_bf16(float lo, float hi) { unsigned r; asm volatile("v_cvt_pk_bf16_f32 %0, %1, %2" : "=v"(r) : "v"(lo), "v"(hi)); return r; }
typedef unsigned u32x2 __attribute__((ext_vector_type(2)));
__device__ __forceinline__ float fsigmoid(float x) { return __builtin_amdgcn_rcpf(1.0f + __expf(-x)); }
__device__ __forceinline__ float fsilu(float x) { return x * fsigmoid(x); }
__device__ __forceinline__ float fgelu_tanh(float x) { const float u = 0.7978845608028654f * (x + 0.044715f * x * x * x); return x * fsigmoid(2.0f * u); }
__device__ __forceinline__ float bf_lo(unsigned w) { return __uint_as_float(w << 16); }
__device__ __forceinline__ float bf_hi(unsigned w) { return __uint_as_float(w & 0xffff0000u); }

constexpr int PROJ_LD = 15360;
struct EpiProj {
    static constexpr bool PERM = true, AFTER_DRAIN = false;
    bf16_t* O; const float* cs; const float* gate_b;
    __device__ __forceinline__ void operator()(const f32x4 (&acc)[2][2][4][2], const Unit& u, int wr, int wc, int fr, int fq) const {
        const int row0 = u.pm * BM + wr * 64 + fr, colb = u.pn * BM + wc * 32 + 8 * fq, kind = u.pn;
#pragma unroll
        for (int ai = 0; ai < 2; ++ai)
#pragma unroll
            for (int m = 0; m < 4; ++m) { const int row = row0 + ai * HALF + m * 16; bf16_t* rowp = O + (size_t)row * PROJ_LD + colb;
#pragma unroll
                for (int bj = 0; bj < 2; ++bj) { f32x4 v0 = acc[ai][bj][m][0], v1 = acc[ai][bj][m][1];
                    if (kind < 8) {
                        const int j0 = 64 * bj + 16 * wc + 4 * fq;
                        const f32x4 c01 = *(const f32x4*)(cs + ((size_t)row * 128 + j0) * 2), c23 = *(const f32x4*)(cs + ((size_t)row * 128 + j0 + 2) * 2);
                        const float sc = kind < 4 ? 1.0f : 0.0625f;
                        f32x4 o0, o1;
                        o0[0] = (v0[0] * c01[0] - v0[1] * c01[1]) * sc; o0[1] = (v0[0] * c01[1] + v0[1] * c01[0]) * sc;
                        o0[2] = (v0[2] * c01[2] - v0[3] * c01[3]) * sc; o0[3] = (v0[2] * c01[3] + v0[3] * c01[2]) * sc;
                        o1[0] = (v1[0] * c23[0] - v1[1] * c23[1]) * sc; o1[1] = (v1[0] * c23[1] + v1[1] * c23[0]) * sc;
                        o1[2] = (v1[2] * c23[2] - v1[3] * c23[3]) * sc; o1[3] = (v1[2] * c23[3] + v1[3] * c23[2]) * sc;
                        v0 = o0; v1 = o1;
                    } else if (kind >= 12 && kind < 16) {
#pragma unroll
                        for (int j = 0; j < 4; ++j) { v0[j] = fsilu(v0[j]); v1[j] = fsilu(v1[j]); }
                    } else if (kind >= 16 && kind < 20) {
                        v0 = v0 * 0.08838834764831845f; v1 = v1 * 0.08838834764831845f;
                    } else if (kind >= 32 && kind < 36) {
#pragma unroll
                        for (int j = 0; j < 4; ++j) { v0[j] = fgelu_tanh(v0[j]); v1[j] = fgelu_tanh(v1[j]); }
                    } else if (kind >= 36) {
                        const int gc = colb + bj * HALF - 9216;
                        const f32x4 b0 = *(const f32x4*)(gate_b + gc), b1 = *(const f32x4*)(gate_b + gc + 4);
#pragma unroll
                        for (int j = 0; j < 4; ++j) { v0[j] = fsigmoid(v0[j] + b0[j]); v1[j] = fsigmoid(v1[j] + b1[j]); }
                    }
                    u32x4 w; w.x = cvt_pk_bf16(v0[0], v0[1]); w.y = cvt_pk_bf16(v0[2], v0[3]); w.z = cvt_pk_bf16(v1[0], v1[1]); w.w = cvt_pk_bf16(v1[2], v1[3]);
                    *(u32x4*)(rowp + bj * HALF) = w; } }
    }
};
struct EpiRes {
    static constexpr bool PERM = false, AFTER_DRAIN = false;
    const float* H; float* Y; float alpha;
    __device__ __forceinline__ void operator()(const f32x4 (&acc)[2][2][4][2], const Unit& u, int wr, int wc, int fr, int fq) const {
        const int row0 = u.pm * BM + wr * 64 + fr, col0 = u.pn * BM + wc * 32 + 4 * fq;
#pragma unroll
        for (int ai = 0; ai < 2; ++ai)
#pragma unroll
            for (int m = 0; m < 4; ++m) { const size_t off = (size_t)(row0 + ai * HALF + m * 16) * 2048 + col0;
#pragma unroll
                for (int bj = 0; bj < 2; ++bj)
#pragma unroll
                    for (int n = 0; n < 2; ++n) { const f32x4 hv = *(const f32x4*)(H + off + bj * HALF + n * 16); *(f32x4*)(Y + off + bj * HALF + n * 16) = hv * alpha + acc[ai][bj][m][n]; }
                asm volatile("" ::: "memory"); }
    }
};
struct EpiSwiglu {
    static constexpr bool PERM = true, AFTER_DRAIN = false;
    bf16_t* O;
    __device__ __forceinline__ void operator()(const f32x4 (&acc)[2][2][4][2], const Unit& u, int wr, int wc, int fr, int fq) const {
        const int row0 = u.pm * BM + wr * 64 + fr, colb = (u.pn * BM + wc * 32 + 8 * fq) >> 1;
#pragma unroll
        for (int ai = 0; ai < 2; ++ai)
#pragma unroll
            for (int m = 0; m < 4; ++m) { bf16_t* rowp = O + (size_t)(row0 + ai * HALF + m * 16) * 5632 + colb;
#pragma unroll
                for (int bj = 0; bj < 2; ++bj) { const f32x4 g = acc[ai][bj][m][0], v = acc[ai][bj][m][1];
                    u32x2 w; w.x = cvt_pk_bf16(fsilu(g[0]) * v[0], fsilu(g[1]) * v[1]); w.y = cvt_pk_bf16(fsilu(g[2]) * v[2], fsilu(g[3]) * v[3]);
                    *(u32x2*)(rowp + bj * (HALF / 2)) = w; } }
    }
};
template <int PASS> struct EpiMerge {
    static constexpr bool PERM = true, AFTER_DRAIN = false;
    const bf16_t* G; float* Mf; bf16_t* Mb;
    __device__ __forceinline__ void operator()(const f32x4 (&acc)[2][2][4][2], const Unit& u, int wr, int wc, int fr, int fq) const {
        const int row0 = u.pm * BM + wr * 64 + fr, colb = u.pn * BM + wc * 32 + 8 * fq;
#pragma unroll
        for (int ai = 0; ai < 2; ++ai)
#pragma unroll
            for (int m = 0; m < 4; ++m) { const int row = row0 + ai * HALF + m * 16;
#pragma unroll
                for (int bj = 0; bj < 2; ++bj) { const int col = colb + bj * HALF;
                    const u32x4 gw = *(const u32x4*)(G + (size_t)row * PROJ_LD + col);
                    f32x4 g0, g1; g0[0] = bf_lo(gw.x); g0[1] = bf_hi(gw.x); g0[2] = bf_lo(gw.y); g0[3] = bf_hi(gw.y); g1[0] = bf_lo(gw.z); g1[1] = bf_hi(gw.z); g1[2] = bf_lo(gw.w); g1[3] = bf_hi(gw.w);
                    f32x4 m0 = g0 * acc[ai][bj][m][0], m1 = g1 * acc[ai][bj][m][1];
                    float* mp = Mf + (size_t)row * 2048 + col;
                    if (PASS > 0) { m0 = m0 + *(const f32x4*)mp; m1 = m1 + *(const f32x4*)(mp + 4); }
                    if (PASS < 2) { *(f32x4*)mp = m0; *(f32x4*)(mp + 4) = m1; }
                    else { u32x4 w; w.x = cvt_pk_bf16(m0[0], m0[1]); w.y = cvt_pk_bf16(m0[2], m0[3]); w.z = cvt_pk_bf16(m1[0], m1[1]); w.w = cvt_pk_bf16(m1[2], m1[3]);
                        *(u32x4*)(Mb + (size_t)row * 2048 + col) = w; } }
                asm volatile("" ::: "memory"); }
    }
};
template <class Epi, class Sched, bool ALIGN_EPI = false, bool SP2 = false>
__device__ __forceinline__ void gemm_phase(PG8_LAS unsigned char* lds, const Gemm g, const Sched& S, const Epi& E, int tid_in) {
    int tid_ = tid_in; asm volatile("" : "+v"(tid_)); const int tid = tid_, wid = __builtin_amdgcn_readfirstlane(tid >> 6), lane = tid & 63, wr = wid >> 2, wc = wid & 3, fr = lane & 15, fq = lane >> 4;
    const int K = g.K, nt = K / BK;
    unsigned voffA[2], voffB[2];
#pragma unroll
    for (int i = 0; i < 2; ++i) { int R, C; stage_rc(tid * 16 + i * 8192, R, C); const int Rb = Epi::PERM ? ((R & ~31) + perm32(R & 31)) : R;
        voffA[i] = (unsigned)(R * g.lda + C) * 2u; voffB[i] = (unsigned)(Rb * g.ldb + C) * 2u; }
    const size_t kstep = (size_t)(BK * 2);
    const size_t hstepA = (size_t)HALF * g.lda * 2, hstepB = (size_t)HALF * g.ldb * 2;
    const size_t tstepA = 2 * hstepA, tstepB = 2 * hstepB;
    const unsigned ldsw = (unsigned)wid * 1024u;
    const int aoff = lds_byte(wr * 64 + fr, fq * 8), boff = lds_byte(wc * 32 + fr, fq * 8);
#define PG8_SA(b, h) (((b) * 2 + (h)) * HTB)
#define PG8_SB(b, h) ((4 + (b) * 2 + (h)) * HTB)
#define PG8_STAGE(bufoff, gbase, voff) do { _Pragma("unroll") for (int _i = 0; _i < 2; ++_i) \
        __builtin_amdgcn_global_load_lds((const unsigned*)((const char*)(gbase) + (voff)[_i]), (PG8_LAS unsigned*)(lds + (bufoff) + ldsw + _i * 8192), 16, 0, 0); } while (0)
#define PG8_LDA(dst, b, h) do { _Pragma("unroll") for (int m = 0; m < 4; ++m) _Pragma("unroll") for (int k = 0; k < 2; ++k) dst[m][k] = *(const PG8_LAS bf16x8*)(lds + PG8_SA(b, h) + aoff + m * 2048 + k * 1024); } while (0)
#define PG8_LDB(dst, b, h) do { _Pragma("unroll") for (int n = 0; n < 2; ++n) _Pragma("unroll") for (int k = 0; k < 2; ++k) dst[n][k] = *(const PG8_LAS bf16x8*)(lds + PG8_SB(b, h) + boff + n * 2048 + k * 1024); } while (0)
#define PG8_MMA(ai, bj, At, Bt) do { __builtin_amdgcn_s_setprio(1); _Pragma("unroll") for (int m = 0; m < 4; ++m) _Pragma("unroll") for (int n = 0; n < 2; ++n) _Pragma("unroll") for (int k = 0; k < 2; ++k) \
        acc[ai][bj][m][n] = __builtin_amdgcn_mfma_f32_16x16x32_bf16(Bt[n][k], At[m][k], acc[ai][bj][m][n], 0, 0, 0); __builtin_amdgcn_s_setprio(0); } while (0)
#define PG8_WAIT_V(n) asm volatile("s_waitcnt vmcnt(" #n ")" ::: "memory")
#define PG8_WAIT_L(n) asm volatile("s_waitcnt lgkmcnt(" #n ")" ::: "memory")
#define PG8_BAR __builtin_amdgcn_s_barrier()
#define PG8_SCHED __builtin_amdgcn_sched_barrier(0)
    Unit cur, nxt; int ui = 0;
    if (!S.next(0, cur)) return;
    f32x4 acc[2][2][4][2];
#pragma unroll
    for (int a = 0; a < 2; ++a)
#pragma unroll
        for (int b = 0; b < 2; ++b)
#pragma unroll
            for (int m = 0; m < 4; ++m)
#pragma unroll
                for (int n = 0; n < 2; ++n) acc[a][b][m][n] = (f32x4){0.f, 0.f, 0.f, 0.f};
    bf16x8 At[4][2], B0[2][2], B1[2][2];
    const char* cA = (const char*)g.A + (size_t)cur.pm * tstepA; const char* cB = (const char*)g.Bt + (size_t)cur.pn * tstepB;
    S.a_ready(cur);
    if constexpr (SP2) {
        PG8_STAGE(PG8_SB(0, 0), cB, voffB); PG8_STAGE(PG8_SB(0, 1), cB + hstepB, voffB); PG8_STAGE(PG8_SA(0, 0), cA, voffA); PG8_STAGE(PG8_SA(0, 1), cA + hstepA, voffA);
        if (wr == 1) PG8_BAR;
        PG8_WAIT_V(2); PG8_BAR;
        PG8_STAGE(PG8_SB(1, 0), cB + kstep, voffB); PG8_STAGE(PG8_SA(1, 0), cA + kstep, voffA); PG8_STAGE(PG8_SB(1, 1), cB + hstepB + kstep, voffB);
        PG8_WAIT_V(6); PG8_BAR;
    } else {
        PG8_STAGE(PG8_SB(0, 0), cB, voffB); PG8_STAGE(PG8_SA(0, 0), cA, voffA); PG8_STAGE(PG8_SB(0, 1), cB + hstepB, voffB); PG8_STAGE(PG8_SA(0, 1), cA + hstepA, voffA);
        if (wr == 1) PG8_BAR;
        PG8_WAIT_V(4); PG8_BAR;
        PG8_STAGE(PG8_SB(1, 0), cB + kstep, voffB); PG8_STAGE(PG8_SA(1, 0), cA + kstep, voffA); PG8_STAGE(PG8_SB(1, 1), cB + hstepB + kstep, voffB);
        PG8_WAIT_V(6); PG8_BAR;
    }
    for (;;) {
        const bool has_next = S.next(ui + 1, nxt);
        const char* nA = has_next ? (const char*)g.A + (size_t)nxt.pm * tstepA : cA; const char* nB = has_next ? (const char*)g.Bt + (size_t)nxt.pn * tstepB : cB;
        for (int t = 0; t < nt; t += 2) {
            const bool last = (t == nt - 2);
            const char* a1 = cA + (size_t)(t + 1) * kstep;
            const char* a2 = last ? nA : cA + (size_t)(t + 2) * kstep; const char* b2 = last ? nB : cB + (size_t)(t + 2) * kstep;
            const char* a3 = a2 + kstep; const char* b3 = b2 + kstep;
            if (last && has_next) S.a_ready(nxt);
            if constexpr (SP2) {
            PG8_LDB(B0, 0, 0); PG8_LDB(B1, 0, 1); PG8_SCHED; PG8_LDA(At, 0, 0); PG8_STAGE(PG8_SA(1, 1), a1 + hstepA, voffA);
            PG8_WAIT_V(8); PG8_WAIT_L(0); PG8_BAR; PG8_MMA(0, 0, At, B0); PG8_MMA(0, 1, At, B1); PG8_BAR; PG8_SCHED;
            PG8_LDA(At, 0, 1); PG8_STAGE(PG8_SB(0, 0), b2, voffB); PG8_STAGE(PG8_SB(0, 1), b2 + hstepB, voffB); PG8_STAGE(PG8_SA(0, 0), a2, voffA);
            PG8_WAIT_V(8); PG8_WAIT_L(0); PG8_BAR; PG8_MMA(1, 0, At, B0); PG8_MMA(1, 1, At, B1); PG8_BAR; PG8_SCHED;
            PG8_LDB(B0, 1, 0); PG8_LDB(B1, 1, 1); PG8_SCHED; PG8_LDA(At, 1, 0); PG8_STAGE(PG8_SA(0, 1), a2 + hstepA, voffA);
            PG8_WAIT_V(8); PG8_WAIT_L(0); PG8_BAR; PG8_MMA(0, 0, At, B0); PG8_MMA(0, 1, At, B1); PG8_BAR; PG8_SCHED;
            PG8_LDA(At, 1, 1); PG8_STAGE(PG8_SB(1, 0), b3, voffB); PG8_STAGE(PG8_SB(1, 1), b3 + hstepB, voffB); PG8_STAGE(PG8_SA(1, 0), a3, voffA);
            PG8_WAIT_V(8); PG8_WAIT_L(0); PG8_BAR; PG8_MMA(1, 0, At, B0); PG8_MMA(1, 1, At, B1); PG8_BAR; PG8_SCHED;
            } else {
            PG8_LDB(B0, 0, 0); PG8_SCHED; PG8_LDA(At, 0, 0); PG8_STAGE(PG8_SA(1, 1), a1 + hstepA, voffA);
            PG8_WAIT_L(8); PG8_BAR; PG8_WAIT_L(0); PG8_MMA(0, 0, At, B0); PG8_BAR; PG8_SCHED;
            PG8_LDB(B1, 0, 1); PG8_STAGE(PG8_SB(0, 0), b2, voffB);
            PG8_BAR; PG8_WAIT_L(0); PG8_MMA(0, 1, At, B1); PG8_BAR;
            PG8_LDA(At, 0, 1); PG8_STAGE(PG8_SA(0, 0), a2, voffA);
            PG8_BAR; PG8_WAIT_L(0); PG8_MMA(1, 0, At, B0); PG8_BAR; PG8_SCHED;
            PG8_STAGE(PG8_SB(0, 1), b2 + hstepB, voffB);
            PG8_WAIT_V(6); PG8_BAR; PG8_MMA(1, 1, At, B1); PG8_BAR;
            PG8_LDB(B0, 1, 0); PG8_SCHED; PG8_LDA(At, 1, 0); PG8_STAGE(PG8_SA(0, 1), a2 + hstepA, voffA);
            PG8_WAIT_L(8); PG8_BAR; PG8_WAIT_L(0); PG8_MMA(0, 0, At, B0); PG8_BAR; PG8_SCHED;
            PG8_LDB(B1, 1, 1); PG8_STAGE(PG8_SB(1, 0), b3, voffB);
            PG8_BAR; PG8_WAIT_L(0); PG8_MMA(0, 1, At, B1); PG8_BAR;
            PG8_LDA(At, 1, 1); PG8_STAGE(PG8_SA(1, 0), a3, voffA);
            PG8_BAR; PG8_WAIT_L(0); PG8_MMA(1, 0, At, B0); PG8_BAR; PG8_SCHED;
            PG8_STAGE(PG8_SB(1, 1), b3 + hstepB, voffB);
            PG8_WAIT_V(6); PG8_BAR; PG8_MMA(1, 1, At, B1); PG8_BAR;
            }
        }
        if constexpr (ALIGN_EPI) { if (wr == 0) PG8_BAR; }
        if constexpr (!Epi::AFTER_DRAIN) { E(acc, cur, wr, wc, fr, fq); S.done(cur); }
        if (!has_next) break;
#pragma unroll
        for (int a = 0; a < 2; ++a)
#pragma unroll
            for (int b = 0; b < 2; ++b)
#pragma unroll
                for (int m = 0; m < 4; ++m)
#pragma unroll
                    for (int n = 0; n < 2; ++n) acc[a][b][m][n] = (f32x4){0.f, 0.f, 0.f, 0.f};
        cur = nxt; cA = nA; cB = nB; ++ui;
        if constexpr (ALIGN_EPI) { if (wr == 1) PG8_BAR; }
    }
    PG8_WAIT_V(0);
    if constexpr (!ALIGN_EPI) { if (wr == 0) PG8_BAR; }
    PG8_BAR;
    if constexpr (Epi::AFTER_DRAIN) { E.fused(acc, cur, wr, wc, fr, fq, lds, wid, lane); S.done(cur); }
#undef PG8_SA
#undef PG8_SB
#undef PG8_STAGE
#undef PG8_LDA
#undef PG8_LDB
#undef PG8_MMA
#undef PG8_WAIT_V
#undef PG8_WAIT_L
#undef PG8_BAR
#undef PG8_SCHED
}
}
#define LAS __attribute__((address_space(3)))
#define XB_TMO      128
#define XB_XCNT(j)  (256  + 64 * (j))
#define XB_XSUB(j)  (1280 + 64 * (j))
#define XB_XGEN(j)  (2304 + 64 * (j))
#define XB_TOP      3328
#define XB_TOPGEN   3392
#define XCD_BAR_WORDS 3456
#define XB_SPIN_CAP (1u << 18)

__device__ __forceinline__ unsigned xb_ld(unsigned* p)              { return __hip_atomic_load(p, __ATOMIC_RELAXED, __HIP_MEMORY_SCOPE_AGENT); }
__device__ __forceinline__ unsigned xb_add(unsigned* p, unsigned v) { return __hip_atomic_fetch_add(p, v, __ATOMIC_RELAXED, __HIP_MEMORY_SCOPE_AGENT); }
__device__ __forceinline__ unsigned xb_xcc_id() { return (unsigned)__builtin_amdgcn_s_getreg((3 << 11) | 20) & 0xFu; }
#define XB_SPIN(cond, bar) do { unsigned _sp = 0; while (cond) { __builtin_amdgcn_s_sleep(1); \
    if ((++_sp & 255u) == 0u) { if (xb_ld(&(bar)[XB_TMO])) break; if (_sp > XB_SPIN_CAP) { atomicAdd(&(bar)[XB_TMO], 1u); break; } } } } while (0)

struct XcdBarrier {
    unsigned* bar; unsigned x;
    volatile LAS unsigned* st;
};

__device__ __forceinline__ XcdBarrier xcd_barrier_post(unsigned* bar, volatile LAS unsigned* st) {
    XcdBarrier b; b.bar = bar; b.x = xb_xcc_id(); b.st = st;
    if (threadIdx.x == 0) (void)xb_add(&bar[XB_XCNT(b.x)], 1u);
    return b;
}
__device__ __forceinline__ void xcd_barrier_complete(unsigned* bar, unsigned x, unsigned& nloc, unsigned& nx) {
    const unsigned G = gridDim.x * gridDim.y * gridDim.z;
    unsigned sum, cnt, mine, sp = 0u;
    for (;;) {
        sum = 0u; cnt = 0u; mine = 0u;
#pragma unroll
        for (unsigned j = 0; j < 16; ++j) { const unsigned c = xb_ld(&bar[XB_XCNT(j)]); sum += c; cnt += (c > 0u) ? 1u : 0u; mine = (j == x) ? c : mine; }
        if (sum == G) break;
        __builtin_amdgcn_s_sleep(1);
        if ((++sp & 255u) == 0u) { if (xb_ld(&bar[XB_TMO])) break; if (sp > XB_SPIN_CAP) { atomicAdd(&bar[XB_TMO], 1u); break; } }
    }
    nloc = mine > 0u ? mine : 1u; nx = cnt > 0u ? cnt : 1u;
}

__device__ __forceinline__ void xcd_barrier(const XcdBarrier& b, const int tid_x) {
    asm volatile("s_waitcnt vmcnt(0)" ::: "memory");
    __syncthreads();
    if (tid_x == 0) {
        unsigned* bar = b.bar;
        __builtin_amdgcn_s_waitcnt(0);
        unsigned nloc = b.st[0], nx = b.st[1];
        if (nloc == 0u) { xcd_barrier_complete(bar, b.x, nloc, nx); b.st[0] = nloc; b.st[1] = nx; }
        const unsigned old = xb_add(&bar[XB_XSUB(b.x)], 1u);
        const unsigned gen = old / nloc;
        if (old + 1u == (gen + 1u) * nloc) {
            __builtin_amdgcn_fence(__ATOMIC_RELEASE, "agent");
            asm volatile("s_waitcnt vmcnt(0)" ::: "memory");
            const unsigned og = xb_add(&bar[XB_TOP], 1u);
            const unsigned tg = og / nx;
            if (og + 1u == (tg + 1u) * nx) xb_add(&bar[XB_TOPGEN], 1u);
            else XB_SPIN(xb_ld(&bar[XB_TOPGEN]) == tg, bar);
            __builtin_amdgcn_fence(__ATOMIC_ACQUIRE, "agent");
            xb_add(&bar[XB_XGEN(b.x)], 1u);
            asm volatile("s_waitcnt vmcnt(0)" ::: "memory");
        } else {
            XB_SPIN(xb_ld(&bar[XB_XGEN(b.x)]) == gen, bar);
            __builtin_amdgcn_fence(__ATOMIC_ACQUIRE, "agent");
            asm volatile("s_waitcnt vmcnt(0)" ::: "memory");
        }
    }
    __syncthreads();
}
__device__ const float INVF[128] = { 1.000000000e+00f, 9.305720329e-01f, 8.659643531e-01f, 8.058421612e-01f, 7.498942614e-01f, 6.978306174e-01f, 6.493816376e-01f, 6.042963862e-01f, 5.623413324e-01f, 5.232990980e-01f, 4.869675338e-01f, 4.531583786e-01f, 4.216965139e-01f, 3.924189806e-01f, 3.651741147e-01f, 3.398208320e-01f, 3.162277639e-01f, 2.942726910e-01f, 2.738419771e-01f, 2.548296750e-01f, 2.371373773e-01f, 2.206734121e-01f, 2.053525001e-01f, 1.910953075e-01f, 1.778279394e-01f, 1.654817164e-01f, 1.539926529e-01f, 1.433012486e-01f, 1.333521307e-01f, 1.240937784e-01f, 1.154782027e-01f, 1.074607819e-01f, 1.000000015e-01f, 9.305720776e-02f, 8.659642935e-02f, 8.058421314e-02f, 7.498941571e-02f, 6.978306174e-02f, 6.493816525e-02f, 6.042964011e-02f, 5.623413250e-02f, 5.232991278e-02f, 4.869675264e-02f, 4.531583562e-02f, 4.216965288e-02f, 3.924189508e-02f, 3.651741147e-02f, 3.398208320e-02f, 3.162277490e-02f, 2.942727134e-02f, 2.738419734e-02f, 2.548296750e-02f, 2.371373773e-02f, 2.206734009e-02f, 2.053525113e-02f, 1.910952851e-02f, 1.778279431e-02f, 1.654816978e-02f, 1.539926510e-02f, 1.433012541e-02f, 1.333521493e-02f, 1.240937784e-02f, 1.154782064e-02f, 1.074607857e-02f, 9.999999776e-03f, 9.305720218e-03f, 8.659643121e-03f, 8.058422245e-03f, 7.498941850e-03f, 6.978305988e-03f, 6.493816152e-03f, 6.042963825e-03f, 5.623413250e-03f, 5.232991185e-03f, 4.869675264e-03f, 4.531583283e-03f, 4.216964822e-03f, 3.924189601e-03f, 3.651741194e-03f, 3.398208413e-03f, 3.162277630e-03f, 2.942727180e-03f, 2.738419687e-03f, 2.548296936e-03f, 2.371373586e-03f, 2.206734149e-03f, 2.053524833e-03f, 1.910952968e-03f, 1.778279431e-03f, 1.654817141e-03f, 1.539926510e-03f, 1.433012541e-03f, 1.333521446e-03f, 1.240937738e-03f, 1.154781901e-03f, 1.074607833e-03f, 1.000000047e-03f, 9.305720450e-04f, 8.659643354e-04f, 8.058421663e-04f, 7.498942432e-04f, 6.978305755e-04f, 6.493816618e-04f, 6.042963942e-04f, 5.623413017e-04f, 5.232990952e-04f, 4.869675322e-04f, 4.531583691e-04f, 4.216965172e-04f, 3.924189659e-04f, 3.651741426e-04f, 3.398208355e-04f, 3.162277571e-04f, 2.942727006e-04f, 2.738419571e-04f, 2.548296761e-04f, 2.371373703e-04f, 2.206734061e-04f, 2.053525095e-04f, 1.910952997e-04f, 1.778279402e-04f, 1.654817170e-04f, 1.539926452e-04f, 1.433012512e-04f, 1.333521504e-04f, 1.240937709e-04f, 1.154782003e-04f, 1.074607862e-04f };

#ifndef PG8_SP2
#define PG8_SP2 true
#endif
#ifndef PG8_ALIGN
#define PG8_ALIGN true
#endif
#ifndef MK_PER_PHASE
#define MK_PER_PHASE 1
#endif

constexpr int SEQ = 8192, DM = 2048, INC = 15360, DFF = 5632, DEPTH = 4, NWAVES = 8, NTHR = 512;
constexpr float LN_EPS = 1e-5f, DN_ALPHA = 1.681792830507429f;
constexpr int C_RQ = 0, C_RK = 1024, C_RV = 2048, C_RG = 3072, C_NQ = 4096, C_NK = 5120, C_NV = 6144, C_LX = 7168, C_LY = 8192, C_GATE = 9216;
constexpr int N_PHASES = 1 + 10 * DEPTH;
constexpr size_t MiB = 1u << 20;
constexpr size_t SZ_WIN = (size_t)INC * DM * 2, SZ_WBR = (size_t)3 * DM * 1024 * 2, SZ_WOUT = (size_t)DM * DM * 2, SZ_WFI = (size_t)2 * DFF * DM * 2, SZ_WFO = (size_t)DM * DFF * 2;
constexpr size_t LO_WIN = 0, LO_WBR = LO_WIN + SZ_WIN, LO_WOUT = LO_WBR + SZ_WBR, LO_WFI = LO_WOUT + SZ_WOUT, LO_WFO = LO_WFI + SZ_WFI, LAYER_W = LO_WFO + SZ_WFO;
constexpr size_t LRUW_LAYER = (size_t)2 * 2 * 8 * 16384;
constexpr size_t WS_CTL = 0, CTL_ZERO_BYTES = 1 * MiB;
constexpr size_t WS_W = 1 * MiB;
constexpr size_t WS_LRUW = WS_W + DEPTH * LAYER_W;
constexpr size_t WS_CS = WS_LRUW + DEPTH * LRUW_LAYER * 2;
constexpr size_t WS_H = WS_CS + 8 * MiB;
constexpr size_t WS_HB = WS_H + 64 * MiB;
constexpr size_t WS_Y = WS_HB + 32 * MiB;
constexpr size_t WS_P = WS_Y + 64 * MiB;
constexpr size_t WS_BR = WS_P + 240 * MiB;
constexpr size_t WS_MF = WS_BR + 48 * MiB;
constexpr size_t WS_MB = WS_MF + 64 * MiB;
constexpr size_t WS_ACT = WS_MB + 32 * MiB;
constexpr size_t WS_KV = WS_ACT + 88 * MiB;
constexpr size_t WS_PREV = WS_KV + 128 * MiB;
constexpr size_t WS_LH = WS_PREV + 64 * MiB;
constexpr size_t WS_LSUM = WS_LH + 128 * MiB;
constexpr size_t WS_LCAR = WS_LSUM + 2 * MiB;
constexpr size_t WS_END = WS_LCAR + 1 * MiB;
static_assert(WS_LRUW % 256 == 0 && WS_CS % 256 == 0 && LAYER_W % 256 == 0, "alignment");
constexpr int CW_BAR = 4096;
constexpr int RING_BYTES = 131072, MISC_OFF = RING_BYTES + 12288, LDS_BYTES = 147456;


typedef unsigned short bf16;
typedef unsigned u32x4 __attribute__((ext_vector_type(4)));
typedef unsigned u32x2 __attribute__((ext_vector_type(2)));
typedef float f32x4 __attribute__((ext_vector_type(4)));
typedef float f32x2 __attribute__((ext_vector_type(2)));
typedef short bf16x8 __attribute__((ext_vector_type(8)));
typedef short v4i16_t __attribute__((ext_vector_type(4)));
__device__ __forceinline__ int lane_id_v() { int l; asm volatile("v_mbcnt_lo_u32_b32 %0, -1, 0\n\tv_mbcnt_hi_u32_b32 %0, -1, %0" : "=v"(l)); return l; }
#define LDS_WAIT() asm volatile("s_waitcnt lgkmcnt(0)" ::: "memory")

__device__ __forceinline__ unsigned pk2(float lo, float hi) { return pg8::cvt_pk_bf16(lo, hi); }
__device__ __forceinline__ float bflo(unsigned w) { return __uint_as_float(w << 16); }
__device__ __forceinline__ float bfhi(unsigned w) { return __uint_as_float(w & 0xffff0000u); }
__device__ __forceinline__ float bf1(unsigned short b) { return __uint_as_float(((unsigned)b) << 16); }
__device__ __forceinline__ float log1p_pos(float y) { const float z = y / (2.0f + y), z2 = z * z;
    const float ser = 2.0f * z * (1.0f + z2 * (0.33333334f + z2 * (0.2f + z2 * (0.14285715f + z2 * 0.11111111f))));
    return y < 0.25f ? ser : __logf(1.0f + y); }
__device__ __forceinline__ float neg_expm1(float x) { const float p = -x * (1.0f + x * (0.5f + x * (0.16666667f + x * (0.041666668f + x * (0.008333334f + x * 0.0013888889f)))));
    return x > -0.5f ? p : 1.0f - __expf(x); }
__device__ __forceinline__ float softplus(float x) { return fmaxf(x, 0.f) + log1p_pos(__expf(-fabsf(x))); }
__device__ __forceinline__ float log_sigmoid(float x) { return -softplus(-x); }
__device__ __forceinline__ f32x4 mfma16(bf16x8 a, bf16x8 b, f32x4 c) { return __builtin_amdgcn_mfma_f32_16x16x32_bf16(a, b, c, 0, 0, 0); }
__device__ __forceinline__ bf16x8 ldrow(const LAS unsigned char* base, int RS, int r0, int k0, int lane) {
    return *(const LAS bf16x8*)(base + (r0 + (lane & 15)) * RS + (k0 + 8 * (lane >> 4)) * 2);
}
__device__ __forceinline__ bf16x8 ldtr(const LAS unsigned char* base, int RS, int k0, int c0, int lane) {
    const int g = lane >> 4, i = lane & 15, q = i >> 2, p = i & 3;
    const LAS unsigned char* a = base + (k0 + 8 * g + q) * RS + (c0 + 4 * p) * 2;
    const v4i16_t lo = __builtin_amdgcn_ds_read_tr16_b64_v4i16((LAS v4i16_t*)a);
    const v4i16_t hi = __builtin_amdgcn_ds_read_tr16_b64_v4i16((LAS v4i16_t*)(a + 4 * RS));
    return (bf16x8){lo[0], lo[1], lo[2], lo[3], hi[0], hi[1], hi[2], hi[3]};
}
__device__ __forceinline__ float shx(float v, int o, int lane) { return __int_as_float(__builtin_amdgcn_ds_bpermute((lane ^ o) << 2, __float_as_int(v))); }
__device__ __forceinline__ float wave_sum(float v, int lane) {
#pragma unroll
    for (int o = 1; o < 64; o <<= 1) v += shx(v, o, lane);
    return v;
}

template <int PK> __device__ __forceinline__ int dst_row(int n) {
    if (PK == 1) { if (n < 2048) { const int j = n & 255, b = n - j; return b + (j < 128 ? 2 * j : 2 * (j - 128) + 1); } return n; }
    if (PK == 2) { if (n < DFF) return 8 * (n >> 2) + (n & 3); const int v = n - DFF; return 8 * (v >> 2) + 4 + (v & 3); }
    return n;
}
template <int PK> __device__ __forceinline__ void transpose_item(const float* W, int K, int N, bf16* WT, LAS float* scr, int item, int lane) {
    const int nblk = N / 32, kb = item / nblk, nb = item % nblk, k0 = 64 * kb, n0 = 32 * nb;
#pragma unroll 8
    for (int i = 0; i < 32; ++i) { const int kk = 2 * i + (lane >> 5); scr[kk * 33 + (lane & 31)] = W[(size_t)(k0 + kk) * N + n0 + (lane & 31)]; }
    LDS_WAIT(); asm volatile("" ::: "memory");
    const int c = lane & 7;
#pragma unroll
    for (int j = 0; j < 4; ++j) { const int n = (lane >> 3) + 8 * j; const LAS float* s = scr + (8 * c) * 33 + n;
        u32x4 o; o.x = pk2(s[0 * 33], s[1 * 33]); o.y = pk2(s[2 * 33], s[3 * 33]); o.z = pk2(s[4 * 33], s[5 * 33]); o.w = pk2(s[6 * 33], s[7 * 33]);
        *(u32x4*)(WT + (size_t)dst_row<PK>(n0 + n) * K + k0 + 8 * c) = o; }
    LDS_WAIT(); asm volatile("" ::: "memory");
}
__device__ __forceinline__ void ln_row(const float* yrow, const float* gam, const float* bet, float* hrow, bf16* hbrow, float* orow, int lane) {
    const f32x4* yr = (const f32x4*)yrow + lane;
    f32x4 v[8]; float s = 0.f;
#pragma unroll
    for (int j = 0; j < 8; ++j) { v[j] = yr[64 * j]; s += (v[j][0] + v[j][1]) + (v[j][2] + v[j][3]); }
    const float mean = wave_sum(s, lane) * (1.f / DM); float s2 = 0.f;
#pragma unroll
    for (int j = 0; j < 8; ++j) { v[j] = v[j] - mean; s2 += (v[j][0] * v[j][0] + v[j][1] * v[j][1]) + (v[j][2] * v[j][2] + v[j][3] * v[j][3]); }
    const float rstd = 1.f / sqrtf(wave_sum(s2, lane) * (1.f / DM) + LN_EPS);
#pragma unroll
    for (int j = 0; j < 8; ++j) { const f32x4 g = ((const f32x4*)gam)[lane + 64 * j], b = ((const f32x4*)bet)[lane + 64 * j];
        const f32x4 o = v[j] * rstd * g + b;
        ((f32x4*)hrow)[lane + 64 * j] = o; if (orow) ((f32x4*)orow)[lane + 64 * j] = o;
        u32x2 w; w.x = pk2(o[0], o[1]); w.y = pk2(o[2], o[3]); ((u32x2*)hbrow)[lane + 64 * j] = w; }
}
__device__ __forceinline__ void cs_entry(int pos, int j, float* out2) {
    const float angf = (float)pos * INVF[j];
    const double t = (double)angf * 0.15915494309189533577;
    double fr = t - floor(t);
    const double k = rint(fr * 4.0); const double r = fr - k * 0.25;
    const double x = r * 6.28318530717958647693, x2 = x * x;
    const double sn = x * (1.0 + x2 * (-1.0 / 6 + x2 * (1.0 / 120 + x2 * (-1.0 / 5040 + x2 * (1.0 / 362880 + x2 * (-1.0 / 39916800))))));
    const double cn = 1.0 + x2 * (-0.5 + x2 * (1.0 / 24 + x2 * (-1.0 / 720 + x2 * (1.0 / 40320 + x2 * (-1.0 / 3628800 + x2 * (1.0 / 479001600))))));
    const int q = ((int)k) & 3;
    double c, s;
    if (q == 0) { c = cn; s = sn; } else if (q == 1) { c = -sn; s = cn; } else if (q == 2) { c = -cn; s = -sn; } else { c = sn; s = -cn; }
    out2[0] = (float)c; out2[1] = (float)s;
}

__device__ __forceinline__ void stage_tile(LAS unsigned char* dst, int RS, const bf16* src, size_t ld, int rows, int c8n, int tid) {
    for (int idx = tid; idx < rows * c8n; idx += NTHR) { const int r = idx / c8n, c8 = idx - r * c8n;
        *(LAS u32x4*)(dst + r * RS + c8 * 16) = *(const u32x4*)(src + (size_t)r * ld + c8 * 8); }
}

__device__ __forceinline__ void ret_kv_unit(LAS unsigned char* lds, const bf16* P, float* KV, const float* dec, int u, int tid) {
    asm volatile("" : "+v"(tid));
    const int h = u & 3, n = u >> 2, lane = tid & 63, w = tid >> 6, g = lane >> 4, i = lane & 15;
    const size_t t0 = (size_t)n * 128;
    constexpr int RSK = 528, RSV = 272;
    LAS unsigned char* Kt = lds; LAS unsigned char* Vf = lds + 67584; LAS unsigned char* Vb = Vf + 34816;
    const float lgf = log_sigmoid(dec[h]), lgb = log_sigmoid(dec[4 + h]);
    stage_tile(Kt, RSK, P + t0 * INC + C_RK + h * 256, INC, 128, 32, tid);
    for (int eh = 0; eh < 2; ++eh) {
        if (eh) __syncthreads();
        for (int idx = tid; idx < 128 * 16; idx += NTHR) { const int r = idx >> 4, c8 = idx & 15;
            const u32x4 v = *(const u32x4*)(P + (t0 + r) * INC + C_RV + h * 256 + eh * 128 + c8 * 8);
            const float sf = __expf((float)(127 - r) * lgf), sb = __expf((float)r * lgb);
            u32x4 of, ob;
            of.x = pk2(bflo(v.x) * sf, bfhi(v.x) * sf); of.y = pk2(bflo(v.y) * sf, bfhi(v.y) * sf); of.z = pk2(bflo(v.z) * sf, bfhi(v.z) * sf); of.w = pk2(bflo(v.w) * sf, bfhi(v.w) * sf);
            ob.x = pk2(bflo(v.x) * sb, bfhi(v.x) * sb); ob.y = pk2(bflo(v.y) * sb, bfhi(v.y) * sb); ob.z = pk2(bflo(v.z) * sb, bfhi(v.z) * sb); ob.w = pk2(bflo(v.w) * sb, bfhi(v.w) * sb);
            *(LAS u32x4*)(Vf + r * RSV + c8 * 16) = of; *(LAS u32x4*)(Vb + r * RSV + c8 * 16) = ob; }
        __syncthreads();
        for (int dir = 0; dir < 2; ++dir) {
            const LAS unsigned char* Vd = dir ? Vb : Vf;
            f32x4 acc[8][2];
#pragma unroll
            for (int mt = 0; mt < 8; ++mt) { acc[mt][0] = (f32x4){0.f, 0.f, 0.f, 0.f}; acc[mt][1] = (f32x4){0.f, 0.f, 0.f, 0.f}; }
#pragma unroll
            for (int ks = 0; ks < 4; ++ks) {
                const bf16x8 kf0 = ldtr(Kt, RSK, 32 * ks, 32 * w, lane), kf1 = ldtr(Kt, RSK, 32 * ks, 32 * w + 16, lane);
#pragma unroll
                for (int mt = 0; mt < 8; ++mt) { const bf16x8 vf = ldtr(Vd, RSV, 32 * ks, 16 * mt, lane); acc[mt][0] = mfma16(vf, kf0, acc[mt][0]); acc[mt][1] = mfma16(vf, kf1, acc[mt][1]); }
            }
            float* dst = KV + ((size_t)n * 8 + h * 2 + dir) * 65536;
#pragma unroll
            for (int mt = 0; mt < 8; ++mt)
#pragma unroll
                for (int nt = 0; nt < 2; ++nt)
#pragma unroll
                    for (int r = 0; r < 4; ++r) dst[(eh * 128 + 16 * mt + 4 * g + r) * 256 + 32 * w + 16 * nt + i] = acc[mt][nt][r];
        }
    }
    __syncthreads();
}

__device__ __forceinline__ void ret_apply_unit(LAS unsigned char* lds, const bf16* P, const bf16* PREV, bf16* BR, const float* dec, int u, int tid) {
    asm volatile("" : "+v"(tid));
    const int h = u & 3, n = u >> 2, lane = tid & 63, w = tid >> 6, g = lane >> 4, i = lane & 15;
    const size_t t0 = (size_t)n * 128;
    constexpr int RSQ = 528, RSP = 272, RSC = 144;
    LAS unsigned char* Qt = lds; LAS unsigned char* R2 = lds + 67584;
    LAS unsigned char* Kt = R2; LAS unsigned char* Pl = R2; LAS unsigned char* Vh = R2 + 34816; LAS unsigned char* Pc = R2;
    const float lgf2 = log_sigmoid(dec[h]) * 1.4426950408889634f, lgb2 = log_sigmoid(dec[4 + h]) * 1.4426950408889634f;
    stage_tile(Qt, RSQ, P + t0 * INC + C_RQ + h * 256, INC, 128, 32, tid);
    stage_tile(Kt, RSQ, P + t0 * INC + C_RK + h * 256, INC, 128, 32, tid);
    __syncthreads();
    f32x4 s[8];
#pragma unroll
    for (int mt = 0; mt < 8; ++mt) s[mt] = (f32x4){0.f, 0.f, 0.f, 0.f};
#pragma unroll
    for (int ks = 0; ks < 8; ++ks) { const bf16x8 qf = ldrow(Qt, RSQ, 16 * w, 32 * ks, lane);
#pragma unroll
        for (int mt = 0; mt < 8; ++mt) { const bf16x8 kf = ldrow(Kt, RSQ, 16 * mt, 32 * ks, lane); s[mt] = mfma16(kf, qf, s[mt]); } }
    __syncthreads();
    const int a = 16 * w + i;
#pragma unroll
    for (int mt = 0; mt < 8; ++mt) { float p[4];
#pragma unroll
        for (int r = 0; r < 4; ++r) { const int b = 16 * mt + 4 * g + r, df = a - b; const float D = df >= 0 ? exp2f((float)df * lgf2) : exp2f((float)(-df) * lgb2); p[r] = s[mt][r] * D; }
        u32x2 wv; wv.x = pk2(p[0], p[1]); wv.y = pk2(p[2], p[3]);
        *(LAS u32x2*)(Pl + a * RSP + (16 * mt + 4 * g) * 2) = wv; }
    f32x4 acc[16];
#pragma unroll
    for (int mt = 0; mt < 16; ++mt) acc[mt] = (f32x4){0.f, 0.f, 0.f, 0.f};
#pragma unroll
    for (int eh = 0; eh < 2; ++eh) {
        stage_tile(Vh, RSP, P + t0 * INC + C_RV + h * 256 + eh * 128, INC, 128, 16, tid);
        __syncthreads();
#pragma unroll
        for (int ks = 0; ks < 4; ++ks) { const bf16x8 pf = ldrow(Pl, RSP, 16 * w, 32 * ks, lane);
#pragma unroll
            for (int mt = 0; mt < 8; ++mt) { const bf16x8 vf = ldtr(Vh, RSP, 32 * ks, 16 * mt, lane); acc[8 * eh + mt] = mfma16(vf, pf, acc[8 * eh + mt]); } }
        __syncthreads();
    }
#pragma unroll
    for (int dir = 0; dir < 2; ++dir) {
        const bf16* pv = PREV + ((size_t)n * 8 + h * 2 + dir) * 65536;
        const float qd = dir == 0 ? exp2f((float)(a + 1) * lgf2) : exp2f((float)(128 - a) * lgb2);
#pragma unroll
        for (int eh = 0; eh < 2; ++eh) {
            f32x4 X[8];
#pragma unroll
            for (int mt = 0; mt < 8; ++mt) X[mt] = (f32x4){0.f, 0.f, 0.f, 0.f};
            for (int dc = 0; dc < 4; ++dc) {
                stage_tile(Pc, RSC, pv + (size_t)eh * 128 * 256 + dc * 64, 256, 128, 8, tid);
                __syncthreads();
#pragma unroll
                for (int ks = 0; ks < 2; ++ks) { const bf16x8 qf = ldrow(Qt, RSQ, 16 * w, 64 * dc + 32 * ks, lane);
#pragma unroll
                    for (int mt = 0; mt < 8; ++mt) { const bf16x8 pf = ldrow(Pc, RSC, 16 * mt, 32 * ks, lane); X[mt] = mfma16(pf, qf, X[mt]); } }
                __syncthreads();
            }
#pragma unroll
            for (int mt = 0; mt < 8; ++mt) acc[8 * eh + mt] = acc[8 * eh + mt] + X[mt] * qd;
        }
    }
    float sm = 0.f;
#pragma unroll
    for (int mt = 0; mt < 16; ++mt) sm += (acc[mt][0] + acc[mt][1]) + (acc[mt][2] + acc[mt][3]);
    sm += shx(sm, 16, lane); sm += shx(sm, 32, lane);
    const float mean = sm * (1.f / 256.f); float sq = 0.f;
#pragma unroll
    for (int mt = 0; mt < 16; ++mt) { const f32x4 d = acc[mt] - mean; sq += (d[0] * d[0] + d[1] * d[1]) + (d[2] * d[2] + d[3] * d[3]); }
    sq += shx(sq, 16, lane); sq += shx(sq, 32, lane);
    const float rstd = 1.f / sqrtf(sq * (1.f / 256.f) + LN_EPS);
    const size_t tok = t0 + a;
#pragma unroll
    for (int mt = 0; mt < 16; ++mt) { const int e = 16 * mt + 4 * g;
        const u32x2 gw = *(const u32x2*)(P + tok * INC + C_RG + h * 256 + e);
        const f32x4 d = (acc[mt] - mean) * rstd;
        u32x2 o; o.x = pk2(d[0] * bflo(gw.x), d[1] * bfhi(gw.x)); o.y = pk2(d[2] * bflo(gw.y), d[3] * bfhi(gw.y));
        *(u32x2*)(BR + tok * 3072 + h * 256 + e) = o; }
    __syncthreads();
}

__device__ __forceinline__ void na_unit(LAS unsigned char* lds, const bf16* P, const float* rpb, bf16* BR, int u, int tid) {
    asm volatile("" : "+v"(tid));
    const int hd = u & 7, rp = u >> 3, lane = tid & 63, w = tid >> 6, half = w >> 2, j = w & 3, g = lane >> 4, i = lane & 15;
    const int r = 2 * rp + half, rs = min(max(r - 4, 0), 120);
    const int ks0 = j == 0 ? 0 : (j == 1 ? 8 : (j == 2 ? 24 : 32));
    constexpr int RS = 272, RSP = 528;
    LAS unsigned char* Qt = lds; LAS unsigned char* KVt = lds + 34816; LAS unsigned char* Psc = lds + 69632 + w * 8448; LAS float* rpbs = (LAS float*)(lds + 137216);
    for (int idx = tid; idx < 2 * 64 * 16; idx += NTHR) { const int hh = idx >> 10, rr = (idx >> 4) & 63, c8 = idx & 15;
        *(LAS u32x4*)(Qt + hh * 17408 + rr * RS + c8 * 16) = *(const u32x4*)(P + ((size_t)(2 * rp + hh) * 64 + rr) * INC + C_NQ + hd * 128 + c8 * 8); }
    for (int idx = tid; idx < 465; idx += NTHR) rpbs[idx] = rpb[hd * 465 + idx];
    __syncthreads();
    bf16x8 qf[4];
#pragma unroll
    for (int ks = 0; ks < 4; ++ks) qf[ks] = ldrow(Qt + half * 17408, RS, 16 * j, 32 * ks, lane);
    f32x4 s[8][2];
#pragma unroll
    for (int kr = 0; kr < 8; ++kr) { s[kr][0] = (f32x4){0.f, 0.f, 0.f, 0.f}; s[kr][1] = (f32x4){0.f, 0.f, 0.f, 0.f}; }
#pragma unroll
    for (int kr = 0; kr < 8; ++kr) {
        for (int idx = tid; idx < 2 * 64 * 16; idx += NTHR) { const int hh = idx >> 10, rr = (idx >> 4) & 63, c8 = idx & 15; const int rsh = min(max(2 * rp + hh - 4, 0), 120);
            *(LAS u32x4*)(KVt + hh * 17408 + rr * RS + c8 * 16) = *(const u32x4*)(P + ((size_t)(rsh + kr) * 64 + rr) * INC + C_NK + hd * 128 + c8 * 8); }
        __syncthreads();
#pragma unroll
        for (int mt = 0; mt < 2; ++mt)
#pragma unroll
            for (int ks = 0; ks < 4; ++ks) { const bf16x8 kf = ldrow(KVt + half * 17408, RS, ks0 + 16 * mt, 32 * ks, lane); s[kr][mt] = mfma16(kf, qf[ks], s[kr][mt]); }
        __syncthreads();
    }
    const int cq = 16 * j + i, cst = min(max(cq - 8, 0), 48);
    float mx = -1e30f;
#pragma unroll
    for (int kr = 0; kr < 8; ++kr)
#pragma unroll
        for (int mt = 0; mt < 2; ++mt)
#pragma unroll
            for (int q = 0; q < 4; ++q) { const int ck = ks0 + 16 * mt + 4 * g + q; const bool ok = ck >= cst && ck < cst + 16;
                const int dcl = min(max(ck - cq + 15, 0), 30);
                const float v = ok ? s[kr][mt][q] + rpbs[(rs + kr - r + 7) * 31 + dcl] : -1e30f; s[kr][mt][q] = v; mx = fmaxf(mx, v); }
    mx = fmaxf(mx, shx(mx, 16, lane)); mx = fmaxf(mx, shx(mx, 32, lane));
    float sum = 0.f;
#pragma unroll
    for (int kr = 0; kr < 8; ++kr)
#pragma unroll
        for (int mt = 0; mt < 2; ++mt)
#pragma unroll
            for (int q = 0; q < 4; ++q) { const float v = s[kr][mt][q]; const float p = v > -1e29f ? __expf(v - mx) : 0.f; s[kr][mt][q] = p; sum += p; }
    sum += shx(sum, 16, lane); sum += shx(sum, 32, lane);
    const float inv = 1.f / sum;
#pragma unroll
    for (int kr = 0; kr < 8; ++kr)
#pragma unroll
        for (int mt = 0; mt < 2; ++mt) { u32x2 wv; wv.x = pk2(s[kr][mt][0] * inv, s[kr][mt][1] * inv); wv.y = pk2(s[kr][mt][2] * inv, s[kr][mt][3] * inv);
            *(LAS u32x2*)(Psc + i * RSP + (kr * 32 + 16 * mt + 4 * g) * 2) = wv; }
    f32x4 o[8];
#pragma unroll
    for (int mt = 0; mt < 8; ++mt) o[mt] = (f32x4){0.f, 0.f, 0.f, 0.f};
#pragma unroll
    for (int kr = 0; kr < 8; ++kr) {
        for (int idx = tid; idx < 2 * 64 * 16; idx += NTHR) { const int hh = idx >> 10, rr = (idx >> 4) & 63, c8 = idx & 15; const int rsh = min(max(2 * rp + hh - 4, 0), 120);
            *(LAS u32x4*)(KVt + hh * 17408 + rr * RS + c8 * 16) = *(const u32x4*)(P + ((size_t)(rsh + kr) * 64 + rr) * INC + C_NV + hd * 128 + c8 * 8); }
        __syncthreads();
        const bf16x8 pf = ldrow(Psc, RSP, 0, 32 * kr, lane);
#pragma unroll
        for (int mt = 0; mt < 8; ++mt) { const bf16x8 vf = ldtr(KVt + half * 17408, RS, ks0, 16 * mt, lane); o[mt] = mfma16(vf, pf, o[mt]); }
        __syncthreads();
    }
    const size_t tok = (size_t)r * 64 + cq;
#pragma unroll
    for (int mt = 0; mt < 8; ++mt) { u32x2 wv; wv.x = pk2(o[mt][0], o[mt][1]); wv.y = pk2(o[mt][2], o[mt][3]);
        *(u32x2*)(BR + tok * 3072 + 1024 + hd * 128 + 16 * mt + 4 * g) = wv; }
}

__device__ __forceinline__ void lru_unit(LAS unsigned char* lds, const bf16* P, const bf16* LW, const float* wconv, const float* bconv, const float* ba, const float* bi, const float* lam,
                                         float* LH, float* LSUM, int u, int tid) {
    asm volatile("" : "+v"(tid));
    const int nb = u & 7, tc = u >> 3, lane = tid & 63, w = tid >> 6, g = lane >> 4, i = lane & 15;
    const int t0 = 64 * tc, c0 = 128 * nb;
    LAS unsigned char* Xr = lds; LAS unsigned char* XC = lds + 17408; LAS unsigned char* XB = lds + 51200; LAS unsigned char* AL = lds + 68608; LAS unsigned char* IL = lds + 102400;
    for (int idx = tid; idx < 67 * 16; idx += NTHR) { const int rr = idx >> 4, c8 = idx & 15; const int tok = t0 - 2 + rr;
        u32x4 v = (u32x4){0u, 0u, 0u, 0u};
        if (tok >= 0 && tok < SEQ) v = *(const u32x4*)(P + (size_t)tok * INC + C_LX + c0 + c8 * 8);
        *(LAS u32x4*)(Xr + rr * 256 + c8 * 16) = v; }
    __syncthreads();
    { const int c = tid & 127, tq = tid >> 7;
      const float w0 = wconv[c0 + c], w1 = wconv[1024 + c0 + c], w2 = wconv[2048 + c0 + c], w3 = wconv[3072 + c0 + c], bb = bconv[c0 + c];
      for (int tt = 0; tt < 16; ++tt) { const int t = tq * 16 + tt;
          const float x0 = bf1(*(const LAS bf16*)(Xr + (t + 0) * 256 + c * 2)), x1 = bf1(*(const LAS bf16*)(Xr + (t + 1) * 256 + c * 2)),
                      x2 = bf1(*(const LAS bf16*)(Xr + (t + 2) * 256 + c * 2)), x3 = bf1(*(const LAS bf16*)(Xr + (t + 3) * 256 + c * 2));
          const float xc = ((w0 * x0 + w1 * x1) + (w2 * x2 + w3 * x3)) + bb;
          *(LAS float*)(XC + t * 528 + c * 4) = xc; *(LAS bf16*)(XB + t * 272 + c * 2) = (bf16)(pk2(xc, 0.f) & 0xffffu); } }
    __syncthreads();
    for (int dir = 0; dir < 2; ++dir) {
        f32x4 ga[4], gi[4];
#pragma unroll
        for (int nt = 0; nt < 4; ++nt) { ga[nt] = (f32x4){0.f, 0.f, 0.f, 0.f}; gi[nt] = (f32x4){0.f, 0.f, 0.f, 0.f}; }
        const bf16* WA = LW + ((size_t)(0 * 2 + dir) * 8 + nb) * 16384; const bf16* WI = LW + ((size_t)(1 * 2 + dir) * 8 + nb) * 16384;
#pragma unroll
        for (int ks = 0; ks < 4; ++ks) {
            const bf16x8 af = *(const bf16x8*)(WA + (16 * w + i) * 128 + 32 * ks + 8 * g), bfr = *(const bf16x8*)(WI + (16 * w + i) * 128 + 32 * ks + 8 * g);
#pragma unroll
            for (int nt = 0; nt < 4; ++nt) { const bf16x8 xf = ldrow(XB, 272, 16 * nt, 32 * ks, lane); ga[nt] = mfma16(af, xf, ga[nt]); gi[nt] = mfma16(bfr, xf, gi[nt]); }
        }
        const int cl = 16 * w + 4 * g, cg = dir * 1024 + c0 + cl;
        const f32x4 bav = *(const f32x4*)(ba + cg), biv = *(const f32x4*)(bi + cg), lmv = *(const f32x4*)(lam + cg);
        f32x4 sp;
#pragma unroll
        for (int q = 0; q < 4; ++q) sp[q] = softplus(-lmv[q]);
#pragma unroll
        for (int nt = 0; nt < 4; ++nt) { const int t = 16 * nt + i;
            const f32x4 xc4 = *(const LAS f32x4*)(XC + t * 528 + cl * 4);
            f32x4 av, iv;
#pragma unroll
            for (int q = 0; q < 4; ++q) { const float rg = pg8::fsigmoid(ga[nt][q] + bav[q]), ig = pg8::fsigmoid(gi[nt][q] + biv[q]);
                const float la = -8.0f * rg * sp[q]; av[q] = __expf(la); iv[q] = sqrtf(fmaxf(neg_expm1(2.0f * la), 0.f)) * (ig * xc4[q]); }
            *(LAS f32x4*)(AL + t * 528 + cl * 4) = av; *(LAS f32x4*)(IL + t * 528 + cl * 4) = iv; }
        __syncthreads();
        if (tid < 128) { const int c = tid; float hh = 0.f, pp = 1.f;
            float* Hd = LH + (size_t)(2 * dir) * SEQ * 1024; float* Pd = LH + (size_t)(2 * dir + 1) * SEQ * 1024;
            for (int st = 0; st < 64; ++st) { const int t = dir ? 63 - st : st;
                const float av = *(const LAS float*)(AL + t * 528 + c * 4), xv = *(const LAS float*)(IL + t * 528 + c * 4);
                hh = av * hh + xv; pp *= av;
                Hd[(size_t)(t0 + t) * 1024 + c0 + c] = hh; Pd[(size_t)(t0 + t) * 1024 + c0 + c] = pp; }
            LSUM[((size_t)(dir * 128 + tc) * 2 + 0) * 1024 + c0 + c] = pp; LSUM[((size_t)(dir * 128 + tc) * 2 + 1) * 1024 + c0 + c] = hh; }
        __syncthreads();
    }
}

struct Args { const float* in[22]; float* out; unsigned char* ws; int ph_lo, ph_hi; };
enum { I_X = 0, I_LNIN_G, I_LNIN_B, I_WIN, I_GATEB, I_RETDEC, I_WCONV, I_BCONV, I_LRUWA, I_LRUBA, I_LRUWI, I_LRUBI, I_LRULAM, I_RPB, I_WBR, I_WOUT, I_LN1G, I_LN1B, I_WFI, I_WFO, I_LN2G, I_LN2B };

__global__ void __launch_bounds__(NTHR, 2) fwd(Args args) {
    extern __shared__ __attribute__((aligned(16))) unsigned char lds_raw[];
    LAS unsigned char* lds = (LAS unsigned char*)lds_raw;
    volatile LAS unsigned* MISC = (volatile LAS unsigned*)(lds + MISC_OFF);
    const int G = gridDim.x, bx = blockIdx.x, wave_s = __builtin_amdgcn_readfirstlane(threadIdx.x >> 6);
    unsigned char* ws = args.ws;
    unsigned* ctl = (unsigned*)(ws + WS_CTL);
    const int lo = args.ph_lo, hi = args.ph_hi;
    for (int u = threadIdx.x; u < (LDS_BYTES - MISC_OFF) / 4; u += NTHR) ((LAS unsigned*)(lds + MISC_OFF))[u] = 0u;
    __syncthreads();
    XcdBarrier bar; bar.bar = ctl + CW_BAR; bar.x = 0; bar.st = nullptr;
    if (hi - lo > 1) bar = xcd_barrier_post(ctl + CW_BAR, MISC + 8);
#ifndef PHMASK
#define PHMASK 0x7ff
#endif
#define IN(k) (lo <= (k) && (k) < hi)
#define EN(b) ((PHMASK >> (b)) & 1)
#define SEAM(k) do { if ((k) + 1 < hi) { XcdBarrier b2_ = bar; asm volatile("" : "+s"(b2_.bar)); xcd_barrier(b2_, wave_s * 64 + lane_id_v()); } } while (0)

#define PTRS() unsigned char* wsp = ws; asm volatile("" : "+s"(wsp)); const int tid = wave_s * 64 + lane_id_v(); \
    const int lane = tid & 63, wave = __builtin_amdgcn_readfirstlane(tid >> 6), gw = bx * NWAVES + wave, NGW = G * NWAVES, gt = bx * NTHR + tid, NGT = G * NTHR; (void)lane; (void)gw; (void)NGW; (void)gt; (void)NGT; \
    bf16* HB = (bf16*)(wsp + WS_HB); float* H = (float*)(wsp + WS_H); float* Y = (float*)(wsp + WS_Y); \
    bf16* P = (bf16*)(wsp + WS_P); bf16* BR = (bf16*)(wsp + WS_BR); float* MF = (float*)(wsp + WS_MF); bf16* MB = (bf16*)(wsp + WS_MB); bf16* ACT = (bf16*)(wsp + WS_ACT); \
    float* KV = (float*)(wsp + WS_KV); bf16* PREV = (bf16*)(wsp + WS_PREV); float* LH = (float*)(wsp + WS_LH); float* LSUM = (float*)(wsp + WS_LSUM); float* LCAR = (float*)(wsp + WS_LCAR); \
    float* CS = (float*)(wsp + WS_CS); const unsigned char* wl = wsp + WS_W + (size_t)l * LAYER_W; const float* dec = args.in[I_RETDEC] + l * 8; \
    (void)HB; (void)H; (void)Y; (void)P; (void)BR; (void)MF; (void)MB; (void)ACT; (void)KV; (void)PREV; (void)LH; (void)LSUM; (void)LCAR; (void)CS; (void)wl; (void)dec;

    if (EN(10) && IN(0)) {
        const int l = 0; PTRS();
        LAS float* scr = (LAS float*)(lds + wave * 16384);
        constexpr int I_IN = (DM / 64) * (INC / 32), I_BR1 = (1024 / 64) * (DM / 32), I_OUT = (DM / 64) * (DM / 32), I_FI = (DM / 64) * (2 * DFF / 32), I_FO = (DFF / 64) * (DM / 32);
        constexpr int PER_LAYER = I_IN + 3 * I_BR1 + I_OUT + I_FI + I_FO;
        for (int it = gw; it < DEPTH * PER_LAYER; it += NGW) {
            const int l = it / PER_LAYER; int r = it - l * PER_LAYER;
            unsigned char* wl2 = wsp + WS_W + (size_t)l * LAYER_W;
            if (r < I_IN) { transpose_item<1>(args.in[I_WIN] + (size_t)l * DM * INC, DM, INC, (bf16*)(wl2 + LO_WIN), scr, r, lane); continue; } r -= I_IN;
            if (r < 3 * I_BR1) { const int nbr = r / I_BR1; transpose_item<0>(args.in[I_WBR] + ((size_t)l * 3 + nbr) * 1024 * DM, 1024, DM, (bf16*)(wl2 + LO_WBR) + (size_t)nbr * DM * 1024, scr, r - nbr * I_BR1, lane); continue; } r -= 3 * I_BR1;
            if (r < I_OUT) { transpose_item<0>(args.in[I_WOUT] + (size_t)l * DM * DM, DM, DM, (bf16*)(wl2 + LO_WOUT), scr, r, lane); continue; } r -= I_OUT;
            if (r < I_FI) { transpose_item<2>(args.in[I_WFI] + (size_t)l * DM * 2 * DFF, DM, 2 * DFF, (bf16*)(wl2 + LO_WFI), scr, r, lane); continue; } r -= I_FI;
            transpose_item<0>(args.in[I_WFO] + (size_t)l * DFF * DM, DFF, DM, (bf16*)(wl2 + LO_WFO), scr, r, lane);
        }
        for (int it = gw; it < DEPTH * 2 * 2 * 8 * 8; it += NGW) {
            const int item = it & 7, m = it >> 3, nb = m & 7, dir = (m >> 3) & 1, kind = (m >> 4) & 1, l = m >> 5;
            const float* src = (kind ? args.in[I_LRUWI] : args.in[I_LRUWA]) + ((size_t)(l * 2 + dir) * 8 + nb) * 16384;
            bf16* dst = (bf16*)(wsp + WS_LRUW) + (size_t)l * LRUW_LAYER + ((size_t)(kind * 2 + dir) * 8 + nb) * 16384;
            transpose_item<0>(src, 128, 128, dst, scr, item, lane);
        }
        for (int e = gt; e < SEQ * 128; e += NGT) cs_entry(e >> 7, e & 127, CS + (size_t)e * 2);
        for (int m = gw; m < SEQ; m += NGW) ln_row(args.in[I_X] + (size_t)m * DM, args.in[I_LNIN_G], args.in[I_LNIN_B], H + (size_t)m * DM, HB + (size_t)m * DM, nullptr, lane);
        SEAM(0);
    }

    for (int l = 0; l < DEPTH; ++l) {
        const int pb = 1 + 10 * l;
        if (EN(0) && IN(pb + 0)) {
            PTRS();
            pg8::Gemm g{HB, (const bf16*)(wl + LO_WIN), SEQ, INC, DM, DM, DM}; pg8::StaticOrder S; S.init(SEQ, INC, G, bx);
            pg8::EpiProj E{P, CS, args.in[I_GATEB] + (size_t)l * 6144};
            pg8::gemm_phase<pg8::EpiProj, pg8::StaticOrder, PG8_ALIGN, PG8_SP2>(lds, g, S, E, tid);
            SEAM(pb + 0);
        }
        if (EN(1) && IN(pb + 1)) {
            PTRS();
            for (int u = bx; u < 256; u += G) ret_kv_unit(lds, P, KV, dec, u, tid);
            const bf16* LW = (const bf16*)(wsp + WS_LRUW) + (size_t)l * LRUW_LAYER;
            for (int u = bx; u < 1024; u += G)
                lru_unit(lds, P, LW, args.in[I_WCONV] + (size_t)l * 4096, args.in[I_BCONV] + (size_t)l * 1024, args.in[I_LRUBA] + (size_t)l * 2048, args.in[I_LRUBI] + (size_t)l * 2048,
                         args.in[I_LRULAM] + (size_t)l * 2048, LH, LSUM, u, tid);
            for (int u = bx; u < 512; u += G) na_unit(lds, P, args.in[I_RPB] + (size_t)l * 8 * 465, BR, u, tid);
            SEAM(pb + 1);
        }
        if (EN(2) && IN(pb + 2)) {
            PTRS();
            for (int q = gt; q < 131072; q += NGT) {
                const int hd = q >> 14, h = hd >> 1, dir = hd & 1, qq = q & 16383;
                const float c = __expf(128.0f * log_sigmoid(dec[dir * 4 + h]));
                f32x4 s = (f32x4){0.f, 0.f, 0.f, 0.f};
                for (int st = 0; st < 64; ++st) { const int n = dir ? 63 - st : st; const size_t o = ((size_t)n * 8 + hd) * 16384 + qq;
                    u32x2 wv; wv.x = pk2(s[0], s[1]); wv.y = pk2(s[2], s[3]); ((u32x2*)PREV)[o] = wv;
                    const f32x4 kv = ((const f32x4*)KV)[o]; s = s * c + kv; }
            }
            for (int q = gt; q < 2048; q += NGT) { const int dir = q >> 10, c = q & 1023; float cin = 0.f;
                for (int st = 0; st < 128; ++st) { const int tc = dir ? 127 - st : st; const size_t o = (size_t)(dir * 128 + tc);
                    LCAR[o * 1024 + c] = cin; cin = LSUM[(o * 2 + 0) * 1024 + c] * cin + LSUM[(o * 2 + 1) * 1024 + c]; } }
            SEAM(pb + 2);
        }
        if (EN(3) && IN(pb + 3)) {
            PTRS();
            for (int u = bx; u < 256; u += G) ret_apply_unit(lds, P, PREV, BR, dec, u, tid);
            for (int q = gt; q < SEQ * 256; q += NGT) { const int tok = q >> 8, c = (q & 255) * 4, tc = tok >> 6; const size_t o = (size_t)tok * 1024 + c;
                const f32x4 hf = *(const f32x4*)(LH + o), pf = *(const f32x4*)(LH + (size_t)SEQ * 1024 + o), hb = *(const f32x4*)(LH + (size_t)2 * SEQ * 1024 + o), pbk = *(const f32x4*)(LH + (size_t)3 * SEQ * 1024 + o);
                const f32x4 cf = *(const f32x4*)(LCAR + (size_t)tc * 1024 + c), cb = *(const f32x4*)(LCAR + (size_t)(128 + tc) * 1024 + c);
                const u32x2 yw = *(const u32x2*)(P + (size_t)tok * INC + C_LY + c);
                const f32x4 hv = (hf + pf * cf) + (hb + pbk * cb);
                u32x2 ov; ov.x = pk2(hv[0] * bflo(yw.x), hv[1] * bfhi(yw.x)); ov.y = pk2(hv[2] * bflo(yw.y), hv[3] * bfhi(yw.y));
                *(u32x2*)(BR + (size_t)tok * 3072 + 2048 + c) = ov; }
            SEAM(pb + 3);
        }
        if (EN(4) && IN(pb + 4)) {
            PTRS();
            pg8::StaticOrder S; S.init(SEQ, DM, G, bx);
            { pg8::Gemm g{BR, (const bf16*)(wl + LO_WBR), SEQ, DM, 1024, 3072, 1024}; pg8::EpiMerge<0> E{P + C_GATE, MF, MB};
              pg8::gemm_phase<pg8::EpiMerge<0>, pg8::StaticOrder, PG8_ALIGN, PG8_SP2>(lds, g, S, E, tid); }
            { pg8::Gemm g{BR + 1024, (const bf16*)(wl + LO_WBR) + (size_t)DM * 1024, SEQ, DM, 1024, 3072, 1024}; pg8::EpiMerge<1> E{P + C_GATE + 2048, MF, MB};
              pg8::gemm_phase<pg8::EpiMerge<1>, pg8::StaticOrder, PG8_ALIGN, PG8_SP2>(lds, g, S, E, tid); }
            { pg8::Gemm g{BR + 2048, (const bf16*)(wl + LO_WBR) + (size_t)2 * DM * 1024, SEQ, DM, 1024, 3072, 1024}; pg8::EpiMerge<2> E{P + C_GATE + 4096, MF, MB};
              pg8::gemm_phase<pg8::EpiMerge<2>, pg8::StaticOrder, PG8_ALIGN, PG8_SP2>(lds, g, S, E, tid); }
            SEAM(pb + 4);
        }
        if (EN(5) && IN(pb + 5)) {
            PTRS();
            pg8::Gemm g{MB, (const bf16*)(wl + LO_WOUT), SEQ, DM, DM, DM, DM}; pg8::StaticOrder S; S.init(SEQ, DM, G, bx);
            pg8::EpiRes E{H, Y, DN_ALPHA};
            pg8::gemm_phase<pg8::EpiRes, pg8::StaticOrder, PG8_ALIGN, PG8_SP2>(lds, g, S, E, tid);
            SEAM(pb + 5);
        }
        if (EN(6) && IN(pb + 6)) {
            PTRS();
            for (int m = gw; m < SEQ; m += NGW) ln_row(Y + (size_t)m * DM, args.in[I_LN1G] + (size_t)l * DM, args.in[I_LN1B] + (size_t)l * DM, H + (size_t)m * DM, HB + (size_t)m * DM, nullptr, lane);
            SEAM(pb + 6);
        }
        if (EN(7) && IN(pb + 7)) {
            PTRS();
            pg8::Gemm g{HB, (const bf16*)(wl + LO_WFI), SEQ, 2 * DFF, DM, DM, DM}; pg8::StaticOrder S; S.init(SEQ, 2 * DFF, G, bx);
            pg8::EpiSwiglu E{ACT};
            pg8::gemm_phase<pg8::EpiSwiglu, pg8::StaticOrder, PG8_ALIGN, PG8_SP2>(lds, g, S, E, tid);
            SEAM(pb + 7);
        }
        if (EN(8) && IN(pb + 8)) {
            PTRS();
            pg8::Gemm g{ACT, (const bf16*)(wl + LO_WFO), SEQ, DM, DFF, DFF, DFF}; pg8::StaticOrder S; S.init(SEQ, DM, G, bx);
            pg8::EpiRes E{H, Y, DN_ALPHA};
            pg8::gemm_phase<pg8::EpiRes, pg8::StaticOrder, PG8_ALIGN, PG8_SP2>(lds, g, S, E, tid);
            SEAM(pb + 8);
        }
        if (EN(9) && IN(pb + 9)) {
            PTRS();
            float* outp = (l == DEPTH - 1) ? args.out : nullptr;
            for (int m = gw; m < SEQ; m += NGW) ln_row(Y + (size_t)m * DM, args.in[I_LN2G] + (size_t)l * DM, args.in[I_LN2B] + (size_t)l * DM, H + (size_t)m * DM, HB + (size_t)m * DM, outp ? outp + (size_t)m * DM : nullptr, lane);
            SEAM(pb + 9);
        }
    }
#undef IN
#undef SEAM
}

extern "C" void kernel_launch(void* const* d_in, const int* in_sizes, int n_in, void* d_out, int out_size, void* d_ws, size_t ws_size, hipStream_t stream) {
    static int grid = 0;
    if (grid == 0) {
        if (n_in != 22 || out_size != SEQ * DM || ws_size < WS_END) { fprintf(stderr, "kernel_launch: unexpected shapes: n_in %d out %d ws %zu (need %zu)\n", n_in, out_size, ws_size, (size_t)WS_END); grid = -1; return; }
        int dev = 0, cus = 0, per_cu = 0;
        if (hipGetDevice(&dev) != hipSuccess || hipDeviceGetAttribute(&cus, hipDeviceAttributeMultiprocessorCount, dev) != hipSuccess) { grid = -1; return; }
        if (hipFuncSetAttribute((const void*)fwd, hipFuncAttributeMaxDynamicSharedMemorySize, LDS_BYTES) != hipSuccess) { fprintf(stderr, "kernel_launch: hipFuncSetAttribute failed\n"); grid = -1; return; }
        if (hipOccupancyMaxActiveBlocksPerMultiprocessor(&per_cu, (const void*)fwd, NTHR, LDS_BYTES) != hipSuccess || per_cu < 1) fprintf(stderr, "kernel_launch: occupancy query says %d\n", per_cu);
        (void)hipGetLastError();
        grid = cus;
    }
    if (grid < 0) return;
    if (hipMemsetAsync((char*)d_ws + WS_CTL, 0, CTL_ZERO_BYTES, stream) != hipSuccess) return;
    Args a{};
    for (int i = 0; i < 22; ++i) a.in[i] = (const float*)d_in[i];
    a.out = (float*)d_out; a.ws = (unsigned char*)d_ws;
#if MK_PER_PHASE
    for (int p = 0; p < N_PHASES; ++p) { a.ph_lo = p; a.ph_hi = p + 1; hipLaunchKernelGGL(fwd, dim3(grid), dim3(NTHR), LDS_BYTES, stream, a); }
#else
    a.ph_lo = 0; a.ph_hi = N_PHASES; hipLaunchKernelGGL(fwd, dim3(grid), dim3(NTHR), LDS_BYTES, stream, a);
#endif
}
```
